# Optimizing an MI355X kernel written in HIP

```python
import jax
import jax.numpy as jnp
from jax import lax
import numpy as np

D_MODEL = 2048
BATCH = 4
SEQ = 4096
DEPTH = 4
DEC_BATCH = 16
DEC_SEQ = 64
PAST_LEN = 4096

CHUNK = 64
N_MIXERS = 3
N_LAYERS_A = (DEPTH + 2) // 3
N_LAYERS_B = (DEPTH + 1) // 3
N_LAYERS_C = DEPTH // 3
EPS = 1e-6
A_CONV = 3
DN_QK_HEADS = 16
DN_V_HEADS = 32
DN_HEAD_DIM = 128
DN_KEY_DIM = DN_QK_HEADS * DN_HEAD_DIM
DN_VAL_DIM = DN_V_HEADS * DN_HEAD_DIM
DN_CONV = 4
DN_CONV_DIM = 2 * DN_KEY_DIM + DN_VAL_DIM
DN_IN_DIM = DN_CONV_DIM + DN_VAL_DIM + 2 * DN_V_HEADS
DN_CHUNK = 64
ATT_HEADS = 16
ATT_HEAD_DIM = 128
LEFT_CHUNKS = 8
WINDOW = LEFT_CHUNKS * CHUNK
BAND = WINDOW + CHUNK
REL_CLIP = 128
D_FF = 5632
FFN_CONV = 3
PLE_DIM = 256
NEG_INF = -1e30

kernel_name = 'hybrid_streaming_encoder_step'


def rms_norm(x, g):
    xf = x.astype(jnp.float32)
    y = xf * lax.rsqrt(jnp.mean(xf * xf, axis=-1, keepdims=True) + EPS)
    return (y * g.astype(jnp.float32)).astype(x.dtype)


def l2_norm(x):
    xf = x.astype(jnp.float32)
    return xf * lax.rsqrt(jnp.sum(xf * xf, axis=-1, keepdims=True) + EPS)


def causal_dwconv(x, hist, w, b=None):
    width = w.shape[0]
    s = x.shape[1]
    xx = jnp.concatenate([hist.astype(x.dtype), x], axis=1)
    y = sum(xx[:, t:t + s] * w[t] for t in range(width))
    if b is not None:
        y = y + b
    return y, xx[:, s:]


def short_conv_mixer(h, conv_hist, w_in, w_conv, w_out):
    b_gate, c_gate, v = jnp.split(h @ w_in, 3, axis=-1)
    y, new_hist = causal_dwconv(c_gate * v, conv_hist, w_conv)
    return (b_gate * y) @ w_out, new_hist


def chunk_gated_delta_rule(q, k, v, g, beta, state0):
    bsz, s, nh, _ = k.shape
    dv = v.shape[-1]
    pad = (-s) % DN_CHUNK
    nc = (s + pad) // DN_CHUNK

    def to_chunks(t):
        t = jnp.pad(t, [(0, 0), (0, pad)] + [(0, 0)] * (t.ndim - 2))
        t = t.reshape((bsz, nc, DN_CHUNK) + t.shape[2:])
        return jnp.swapaxes(jnp.swapaxes(t, 2, 3), 0, 1)

    qc, kc, vc, gc, bc = (to_chunks(t) for t in (q, k, v, g, beta))
    gcum = jnp.cumsum(gc, axis=-1)
    tril = jnp.tril(jnp.ones((DN_CHUNK, DN_CHUNK), dtype=bool))
    strict = jnp.tril(jnp.ones((DN_CHUNK, DN_CHUNK), dtype=bool), -1)
    diff = gcum[..., :, None] - gcum[..., None, :]
    decay = jnp.where(tril, jnp.exp(jnp.where(tril, diff, 0.0)), 0.0)
    kb = kc * bc[..., None]
    lmat = jnp.where(strict, jnp.einsum('nbhid,nbhjd->nbhij', kb, kc) * decay, 0.0)
    eye = jnp.eye(DN_CHUNK, dtype=lmat.dtype)
    tmat = lax.linalg.triangular_solve(eye + lmat, jnp.broadcast_to(eye, lmat.shape),
                                       left_side=True, lower=True)
    u = jnp.einsum('nbhij,nbhje->nbhie', tmat, vc * bc[..., None])
    w = jnp.einsum('nbhij,nbhjd->nbhid', tmat, kb * jnp.exp(gcum)[..., None])
    a_intra = jnp.where(tril, jnp.einsum('nbhid,nbhjd->nbhij', qc, kc) * decay, 0.0)

    def step(state, inp):
        q_i, k_i, u_i, w_i, g_i, a_i = inp
        v_new = u_i - jnp.einsum('bhcd,bhde->bhce', w_i, state)
        o_i = (jnp.einsum('bhcd,bhde->bhce', q_i * jnp.exp(g_i)[..., None], state)
               + jnp.einsum('bhij,bhje->bhie', a_i, v_new))
        g_last = g_i[..., -1:]
        state = (state * jnp.exp(g_last)[..., None]
                 + jnp.einsum('bhcd,bhce->bhde', k_i * jnp.exp(g_last - g_i)[..., None], v_new))
        return state, o_i

    state, o = lax.scan(step, state0, (qc, kc, u, w, gcum, a_intra))
    o = jnp.transpose(o, (1, 0, 3, 2, 4)).reshape(bsz, nc * DN_CHUNK, nh, dv)[:, :s]
    return o, state


def gated_delta_mixer(h, conv_hist, ssm_state, w_in, w_conv, a_log, dt_bias, g_out, w_out):
    bsz, s, _ = h.shape
    proj = h @ w_in
    qkv, z, b, a = jnp.split(proj, [DN_CONV_DIM, DN_CONV_DIM + DN_VAL_DIM,
                                    DN_CONV_DIM + DN_VAL_DIM + DN_V_HEADS], axis=-1)
    qkv, new_conv = causal_dwconv(qkv, conv_hist, w_conv)
    qkv = jax.nn.silu(qkv)
    q, k, v = jnp.split(qkv, [DN_KEY_DIM, 2 * DN_KEY_DIM], axis=-1)
    rep = DN_V_HEADS // DN_QK_HEADS
    q = jnp.repeat(l2_norm(q.reshape(bsz, s, DN_QK_HEADS, DN_HEAD_DIM)), rep, axis=2) * (DN_HEAD_DIM ** -0.5)
    k = jnp.repeat(l2_norm(k.reshape(bsz, s, DN_QK_HEADS, DN_HEAD_DIM)), rep, axis=2)
    v = v.reshape(bsz, s, DN_V_HEADS, DN_HEAD_DIM).astype(jnp.float32)
    beta = jax.nn.sigmoid(b.astype(jnp.float32))
    g = -jnp.exp(a_log.astype(jnp.float32)) * jax.nn.softplus(a.astype(jnp.float32) + dt_bias.astype(jnp.float32))
    o, new_state = chunk_gated_delta_rule(q, k, v, g, beta, ssm_state.astype(jnp.float32))
    o = rms_norm(o, g_out) * jax.nn.silu(z.reshape(bsz, s, DN_V_HEADS, DN_HEAD_DIM).astype(jnp.float32))
    out = o.reshape(bsz, s, DN_VAL_DIM).astype(h.dtype) @ w_out
    return out, new_conv, new_state.astype(ssm_state.dtype)


def chunk_band_attention(h, k_hist, v_hist, w_qkv, g_q, g_k, rel_bias, w_out):
    bsz, s, _ = h.shape
    qkv = (h @ w_qkv).reshape(bsz, s, 3, ATT_HEADS, ATT_HEAD_DIM)
    q = rms_norm(qkv[:, :, 0], g_q)
    k = rms_norm(qkv[:, :, 1], g_k)
    v = qkv[:, :, 2]
    n_hist = k_hist.shape[1]
    pad_r = (-s) % CHUNK
    nc = (s + pad_r) // CHUNK

    def extend(new, hist):
        return jnp.concatenate([
            jnp.zeros((bsz, WINDOW - n_hist, ATT_HEADS, ATT_HEAD_DIM), new.dtype),
            hist.astype(new.dtype), new,
            jnp.zeros((bsz, pad_r, ATT_HEADS, ATT_HEAD_DIM), new.dtype)], axis=1)

    k_ext = extend(k, k_hist)
    v_ext = extend(v, v_hist)
    q_pad = jnp.pad(q, ((0, 0), (0, pad_r), (0, 0), (0, 0)))
    rows = jnp.arange(WINDOW + nc * CHUNK)
    valid = (rows >= WINDOW - n_hist) & (rows < WINDOW + s)
    rel = WINDOW + jnp.arange(CHUNK)[:, None] - jnp.arange(BAND)[None, :]
    bias = rel_bias.astype(jnp.float32)[:, jnp.clip(rel, -REL_CLIP, REL_CLIP) + REL_CLIP]
    scale = ATT_HEAD_DIM ** -0.5

    def one_chunk(c):
        start = c * CHUNK
        q_c = lax.dynamic_slice_in_dim(q_pad, start, CHUNK, axis=1)
        k_c = lax.dynamic_slice_in_dim(k_ext, start, BAND, axis=1)
        v_c = lax.dynamic_slice_in_dim(v_ext, start, BAND, axis=1)
        m_c = lax.dynamic_slice_in_dim(valid, start, BAND)
        sc = jnp.einsum('bqhd,bkhd->bhqk', q_c, k_c).astype(jnp.float32) * scale + bias
        p = jax.nn.softmax(jnp.where(m_c, sc, NEG_INF), axis=-1)
        return jnp.einsum('bhqk,bkhd->bqhd', p.astype(v_c.dtype), v_c)

    o = lax.map(one_chunk, jnp.arange(nc))
    o = jnp.moveaxis(o, 0, 1).reshape(bsz, nc * CHUNK, ATT_HEADS * ATT_HEAD_DIM)[:, :s]
    return o @ w_out, k, v


def conv_glu_ffn(h, conv_hist, w_up, w_conv, b_conv, w_down):
    u, new_hist = causal_dwconv(h @ w_up, conv_hist, w_conv, b_conv)
    gate, up = jnp.split(u, 2, axis=-1)
    return (jax.nn.silu(gate) * up) @ w_down, new_hist


def per_layer_embed(h, p, g_norm, w_gate, w_proj):
    gate = jax.nn.sigmoid(rms_norm(h, g_norm) @ w_gate)
    return h + (p @ w_proj) * gate


def run_trunk(x, p, conv_a, conv_b, ssm_b, hist_k, hist_v, conv_f, prm):
    h = x
    s = x.shape[1]
    keep = min(WINDOW, s)
    out_a, out_bc, out_bs, out_k, out_v, out_f = [], [], [], [], [], []
    for i in range(DEPTH):
        kind, j = i % N_MIXERS, i // N_MIXERS
        hn = rms_norm(h, prm['g_mix'][i])
        if kind == 0:
            y, st = short_conv_mixer(hn, conv_a[j], prm['w_a_in'][j], prm['w_a_conv'][j], prm['w_a_out'][j])
            out_a.append(st)
        elif kind == 1:
            y, st_c, st_s = gated_delta_mixer(hn, conv_b[j], ssm_b[j], prm['w_b_in'][j], prm['w_b_conv'][j],
                                              prm['b_a_log'][j], prm['b_dt_bias'][j], prm['g_b_out'][j],
                                              prm['w_b_out'][j])
            out_bc.append(st_c)
            out_bs.append(st_s)
        else:
            y, k_new, v_new = chunk_band_attention(hn, hist_k[j], hist_v[j], prm['w_c_qkv'][j], prm['g_c_q'][j],
                                                   prm['g_c_k'][j], prm['c_rel_bias'][j], prm['w_c_out'][j])
            out_k.append(k_new[:, s - keep:])
            out_v.append(v_new[:, s - keep:])
        h = h + y
        y, st = conv_glu_ffn(rms_norm(h, prm['g_ffn'][i]), conv_f[i], prm['w_f_up'][i], prm['w_f_conv'][i],
                             prm['b_f_conv'][i], prm['w_f_down'][i])
        out_f.append(st)
        h = h + y
        h = per_layer_embed(h, p[i], prm['g_ple'][i], prm['w_ple_gate'][i], prm['w_ple_proj'][i])
    return (rms_norm(h, prm['g_final']), jnp.stack(out_a), jnp.stack(out_bc), jnp.stack(out_bs),
            jnp.stack(out_k), jnp.stack(out_v), jnp.stack(out_f))


def setup_inputs(seed: int = 0) -> dict:
    key = jax.random.key(seed)
    ks = iter(jax.random.split(key, 48))

    def nrm(shape, scale):
        return jax.random.normal(next(ks), shape, jnp.float32) * scale

    def gain(shape):
        return 1.0 + nrm(shape, 0.05)

    c_len = min(WINDOW, PAST_LEN)
    out_scale = (2 * DEPTH) ** -0.5
    a_log = jnp.log(jax.random.uniform(next(ks), (N_LAYERS_B, DN_V_HEADS), jnp.float32, 1.0, 16.0))
    dt = jnp.exp(jax.random.uniform(next(ks), (N_LAYERS_B, DN_V_HEADS), jnp.float32,
                                    float(np.log(1e-3)), float(np.log(1e-1))))
    dt_bias = dt + jnp.log(-jnp.expm1(-dt))
    return {
        'x_prompt': nrm((BATCH, SEQ, D_MODEL), 1.0),
        'x_sample': nrm((DEC_BATCH, DEC_SEQ, D_MODEL), 1.0),
        'state_a_conv': nrm((N_LAYERS_A, DEC_BATCH, A_CONV - 1, D_MODEL), 1.0),
        'state_b_conv': nrm((N_LAYERS_B, DEC_BATCH, DN_CONV - 1, DN_CONV_DIM), 1.0),
        'state_b_ssm': nrm((N_LAYERS_B, DEC_BATCH, DN_V_HEADS, DN_HEAD_DIM, DN_HEAD_DIM), 0.1),
        'cache_c_k': nrm((N_LAYERS_C, DEC_BATCH, c_len, ATT_HEADS, ATT_HEAD_DIM), 1.0),
        'cache_c_v': nrm((N_LAYERS_C, DEC_BATCH, c_len, ATT_HEADS, ATT_HEAD_DIM), 1.0),
        'state_ffn_conv': nrm((DEPTH, DEC_BATCH, FFN_CONV - 1, 2 * D_FF), 1.0),
        'p_prompt': nrm((DEPTH, BATCH, SEQ, PLE_DIM), 1.0),
        'p_sample': nrm((DEPTH, DEC_BATCH, DEC_SEQ, PLE_DIM), 1.0),
        'g_mix': gain((DEPTH, D_MODEL)),
        'g_ffn': gain((DEPTH, D_MODEL)),
        'w_a_in': nrm((N_LAYERS_A, D_MODEL, 3 * D_MODEL), D_MODEL ** -0.5),
        'w_a_conv': nrm((N_LAYERS_A, A_CONV, D_MODEL), A_CONV ** -0.5),
        'w_a_out': nrm((N_LAYERS_A, D_MODEL, D_MODEL), D_MODEL ** -0.5 * out_scale),
        'w_b_in': nrm((N_LAYERS_B, D_MODEL, DN_IN_DIM), D_MODEL ** -0.5),
        'w_b_conv': nrm((N_LAYERS_B, DN_CONV, DN_CONV_DIM), DN_CONV ** -0.5),
        'b_a_log': a_log,
        'b_dt_bias': dt_bias,
        'g_b_out': gain((N_LAYERS_B, DN_HEAD_DIM)),
        'w_b_out': nrm((N_LAYERS_B, DN_VAL_DIM, D_MODEL), DN_VAL_DIM ** -0.5 * out_scale),
        'w_c_qkv': nrm((N_LAYERS_C, D_MODEL, 3 * ATT_HEADS * ATT_HEAD_DIM), D_MODEL ** -0.5),
        'g_c_q': gain((N_LAYERS_C, ATT_HEAD_DIM)),
        'g_c_k': gain((N_LAYERS_C, ATT_HEAD_DIM)),
        'c_rel_bias': nrm((N_LAYERS_C, ATT_HEADS, 2 * REL_CLIP + 1), 0.2),
        'w_c_out': nrm((N_LAYERS_C, ATT_HEADS * ATT_HEAD_DIM, D_MODEL), D_MODEL ** -0.5 * out_scale),
        'w_f_up': nrm((DEPTH, D_MODEL, 2 * D_FF), D_MODEL ** -0.5),
        'w_f_conv': nrm((DEPTH, FFN_CONV, 2 * D_FF), FFN_CONV ** -0.5),
        'b_f_conv': nrm((DEPTH, 2 * D_FF), 0.02),
        'w_f_down': nrm((DEPTH, D_FF, D_MODEL), D_FF ** -0.5 * out_scale),
        'g_ple': gain((DEPTH, D_MODEL)),
        'w_ple_gate': nrm((DEPTH, D_MODEL, D_MODEL), D_MODEL ** -0.5),
        'w_ple_proj': nrm((DEPTH, PLE_DIM, D_MODEL), PLE_DIM ** -0.5 * out_scale),
        'g_final': gain((D_MODEL,)),
    }


def reference(x_prompt, x_sample, state_a_conv, state_b_conv, state_b_ssm, cache_c_k, cache_c_v, state_ffn_conv,
              p_prompt, p_sample, g_mix, g_ffn, w_a_in, w_a_conv, w_a_out, w_b_in, w_b_conv, b_a_log, b_dt_bias,
              g_b_out, w_b_out, w_c_qkv, g_c_q, g_c_k, c_rel_bias, w_c_out, w_f_up, w_f_conv, b_f_conv, w_f_down,
              g_ple, w_ple_gate, w_ple_proj, g_final):
    prm = dict(g_mix=g_mix, g_ffn=g_ffn, w_a_in=w_a_in, w_a_conv=w_a_conv, w_a_out=w_a_out, w_b_in=w_b_in,
               w_b_conv=w_b_conv, b_a_log=b_a_log, b_dt_bias=b_dt_bias, g_b_out=g_b_out, w_b_out=w_b_out,
               w_c_qkv=w_c_qkv, g_c_q=g_c_q, g_c_k=g_c_k, c_rel_bias=c_rel_bias, w_c_out=w_c_out, w_f_up=w_f_up,
               w_f_conv=w_f_conv, b_f_conv=b_f_conv, w_f_down=w_f_down, g_ple=g_ple, w_ple_gate=w_ple_gate,
               w_ple_proj=w_ple_proj, g_final=g_final)
    bp = x_prompt.shape[0]
    dt = x_prompt.dtype
    y_prompt, pa, pbc, pbs, pk, pv, pf = run_trunk(
        x_prompt, p_prompt,
        jnp.zeros((N_LAYERS_A, bp, A_CONV - 1, D_MODEL), dt),
        jnp.zeros((N_LAYERS_B, bp, DN_CONV - 1, DN_CONV_DIM), dt),
        jnp.zeros((N_LAYERS_B, bp, DN_V_HEADS, DN_HEAD_DIM, DN_HEAD_DIM), dt),
        jnp.zeros((N_LAYERS_C, bp, 0, ATT_HEADS, ATT_HEAD_DIM), dt),
        jnp.zeros((N_LAYERS_C, bp, 0, ATT_HEADS, ATT_HEAD_DIM), dt),
        jnp.zeros((DEPTH, bp, FFN_CONV - 1, 2 * D_FF), dt),
        prm)
    y_sample, sa, sbc, sbs, sk, sv, sf = run_trunk(
        x_sample, p_sample, state_a_conv, state_b_conv, state_b_ssm, cache_c_k, cache_c_v, state_ffn_conv, prm)
    return (y_prompt, y_sample, pa, pbc, pbs, pk, pv, pf, sa, sbc, sbs, sk, sv, sf)
```

```cpp
#include <hip/hip_runtime.h>
#include <cstdio>
#include <cstdint>

#define LAS __attribute__((address_space(3)))
typedef unsigned short bf16_t;
typedef short bf16x8 __attribute__((ext_vector_type(8)));
typedef float f32x4 __attribute__((ext_vector_type(4)));
typedef float f32x2 __attribute__((ext_vector_type(2)));
typedef unsigned u32x4 __attribute__((ext_vector_type(4)));
typedef unsigned u32x2 __attribute__((ext_vector_type(2)));

constexpr int DM = 2048, SEQ = 4096, DSEQ = 64, NBP = 4, NBS = 16;
constexpr int MP = NBP * SEQ, MS = NBS * DSEQ, MT = MP + MS;
constexpr int DFF = 5632, DFF2 = 11264, PLE = 256;
constexpr int DNC = 8192, DNV = 4096, DNIN = 12352;
constexpr int NTH = 512;
constexpr float EPS = 1e-6f;

enum { I_XP = 0, I_XS, I_STA, I_STBC, I_STBS, I_CK, I_CV, I_STF, I_PP, I_PS, I_GMIX, I_GFFN, I_WAIN, I_WACONV, I_WAOUT, I_WBIN, I_WBCONV, I_ALOG, I_DTB, I_GBOUT, I_WBOUT,
       I_WCQKV, I_GCQ, I_GCK, I_RELB, I_WCOUT, I_WFUP, I_WFCONV, I_BFCONV, I_WFDOWN, I_GPLE, I_WPG, I_WPP, I_GFIN, N_IN };

constexpr size_t O_YP = 0, O_YS = O_YP + (size_t)MP * DM, O_PA = O_YS + (size_t)MS * DM, O_PBC = O_PA + 2 * 4 * 2 * 2048, O_PBS = O_PBC + 4 * 3 * 8192,
                 O_PCK = O_PBS + (size_t)4 * 32 * 128 * 128, O_PCV = O_PCK + (size_t)4 * 512 * 2048, O_PF = O_PCV + (size_t)4 * 512 * 2048, O_SA = O_PF + 4 * 4 * 2 * 11264,
                 O_SBC = O_SA + 2 * 16 * 2 * 2048, O_SBS = O_SBC + 16 * 3 * 8192, O_SCK = O_SBS + (size_t)16 * 32 * 128 * 128, O_SCV = O_SCK + (size_t)16 * 64 * 2048,
                 O_SF = O_SCV + (size_t)16 * 64 * 2048, O_END = O_SF + 4 * 16 * 2 * 11264;
static_assert(O_END == 61177856, "output size");

constexpr size_t al256(size_t x) { return (x + 255) & ~(size_t)255; }
constexpr size_t WS_CTL = 0;
constexpr size_t CTL_BYTES = 65536;
constexpr size_t WS_SS = WS_CTL + CTL_BYTES;
constexpr int NSS = 13;
constexpr size_t SS_BYTES = al256((size_t)NSS * MT * 8);
constexpr size_t ZERO_BYTES = CTL_BYTES + SS_BYTES;
constexpr size_t WS_BA = WS_SS + SS_BYTES;
constexpr size_t WS_WAIN = WS_BA + (size_t)MT * 64 * 4;
constexpr size_t WS_WAOUT = WS_WAIN + (size_t)2 * 6144 * 2048 * 2;
constexpr size_t WS_WBIN = WS_WAOUT + (size_t)2 * 2048 * 2048 * 2;
constexpr size_t WS_WBBA = WS_WBIN + (size_t)12288 * 2048 * 2;
constexpr size_t WS_WBOUT = WS_WBBA + (size_t)64 * 2048 * 2;
constexpr size_t WS_WCQKV = WS_WBOUT + (size_t)2048 * 4096 * 2;
constexpr size_t WS_WCOUT = WS_WCQKV + (size_t)6144 * 2048 * 2;
constexpr size_t WS_WFUP = WS_WCOUT + (size_t)2048 * 2048 * 2;
constexpr size_t WS_WFDOWN = WS_WFUP + (size_t)4 * 11264 * 2048 * 2;
constexpr size_t WS_WPG = WS_WFDOWN + (size_t)4 * 2048 * 5632 * 2;
constexpr size_t WS_WPP = WS_WPG + (size_t)4 * 2048 * 2048 * 2;
constexpr size_t WS_H = WS_WPP + (size_t)4 * 2048 * 256 * 2;
constexpr size_t WS_HB = WS_H + (size_t)MT * DM * 4;
constexpr size_t HB_STRIDE = (size_t)MT * DM * 2;
constexpr size_t WS_PB = WS_HB + 2 * HB_STRIDE;
constexpr size_t WS_ARENA = WS_PB + (size_t)4 * MT * PLE * 2;
constexpr size_t AR_BG = WS_ARENA, AR_CV = AR_BG + (size_t)MT * DM * 2, AR_AA = AR_CV + (size_t)MT * DM * 2, AR_A_END = AR_AA + (size_t)MT * DM * 2;
constexpr size_t AR_QKVP = WS_ARENA, AR_Z = AR_QKVP + (size_t)MT * DNC * 2, AR_ODR = AR_Z + (size_t)MT * DNV * 2, AR_HALO = AR_ODR + (size_t)MT * DNV * 2, AR_B_END = AR_HALO + (size_t)(MT / 64) * 3 * 4096 * 2;
constexpr size_t AR_QKV = WS_ARENA, AR_VTP = AR_QKV + (size_t)MT * 6144 * 2, AR_VTS = AR_VTP + (size_t)4 * 16 * 128 * 4096 * 2, AR_KS = AR_VTS + (size_t)16 * 16 * 128 * 576 * 2,
                 AR_OATT = AR_KS + (size_t)16 * 576 * 2048 * 2, AR_C_END = AR_OATT + (size_t)MT * DM * 2;
constexpr size_t AR_ACT = WS_ARENA, AR_XB = AR_ACT + (size_t)MT * DFF * 2, AR_PPB = AR_XB + (size_t)(MT / 64) * 4 * DFF2 * 4, AR_F_END = AR_PPB + (size_t)MT * DM * 2;
constexpr size_t AR_PART = WS_ARENA + ((size_t)400 << 20), AR_PART_B = WS_ARENA, PART_BYTES = (size_t)256 * 65536 * 4;
constexpr size_t WS_END = AR_B_END > AR_F_END ? (AR_B_END > AR_C_END ? AR_B_END : AR_C_END) : (AR_F_END > AR_C_END ? AR_F_END : AR_C_END);
static_assert(AR_A_END <= WS_END && AR_B_END <= WS_END && AR_C_END <= WS_END && AR_F_END <= WS_END, "arena");
static_assert(AR_A_END <= AR_PART && AR_F_END <= AR_PART && AR_PART + PART_BYTES <= WS_END && AR_PART_B + PART_BYTES <= AR_ODR && AR_PART_B + PART_BYTES <= AR_VTP, "partials");
#ifdef DBG
constexpr size_t WS_HCOPY = WS_END;
constexpr size_t WS_NEED = WS_HCOPY + HB_STRIDE;
#else
constexpr size_t WS_NEED = WS_END;
#endif

struct Params { const float* in[N_IN]; float* out; unsigned char* ws; int pb, pe; };

__device__ __forceinline__ int launder_v(int v) { asm volatile("" : "+v"(v)); return v; }
__device__ __forceinline__ int launder_s(int v) { asm volatile("" : "+s"(v)); return v; }
__device__ __forceinline__ int fresh_tid(int wv) { unsigned z = 0u; asm volatile("" : "+v"(z));
    int t = wv * 64 + (int)__builtin_amdgcn_mbcnt_hi(~0u, __builtin_amdgcn_mbcnt_lo(~0u, z)); asm volatile("" : "+v"(t)); return t; }
__device__ __forceinline__ const Params& fresh(const Params& P) { const Params* p = &P; asm volatile("" : "+s"(p)); return *p; }
__device__ __forceinline__ float bf2f(bf16_t v) { return __uint_as_float(((unsigned)v) << 16); }
__device__ __forceinline__ float bflo(unsigned w) { return __uint_as_float(w << 16); }
__device__ __forceinline__ float bfhi(unsigned w) { return __uint_as_float(w & 0xffff0000u); }
typedef __bf16 bf16x2_t __attribute__((ext_vector_type(2)));
__device__ __forceinline__ unsigned cvt_pk_bf16(float lo, float hi) { const bf16x2_t v = __builtin_convertvector((f32x2){lo, hi}, bf16x2_t); unsigned r; __builtin_memcpy(&r, &v, 4); return r; }
__device__ __forceinline__ bf16_t f2bf(float f) { return (bf16_t)(cvt_pk_bf16(f, 0.f) & 0xffffu); }
__device__ __forceinline__ float sigmoidf_(float x) { return __builtin_amdgcn_rcpf(1.0f + __expf(-x)); }
__device__ __forceinline__ float siluf_(float x) { return x * __builtin_amdgcn_rcpf(1.0f + __expf(-x)); }
#define DPPF(old, v, ctrl, rm) __int_as_float(__builtin_amdgcn_update_dpp(__float_as_int(old), __float_as_int(v), (ctrl), (rm), 0xf, false))
__device__ __forceinline__ float wave_sum(float v) {
    v += DPPF(0.f, v, 0xB1, 0xf);
    v += DPPF(0.f, v, 0x4E, 0xf);
    v += DPPF(0.f, v, 0x141, 0xf);
    v += DPPF(0.f, v, 0x140, 0xf);
    v += DPPF(0.f, v, 0x142, 0xa);
    v += DPPF(0.f, v, 0x143, 0xc);
    return __int_as_float(__builtin_amdgcn_readlane(__float_as_int(v), 63));
}
typedef unsigned long long ssq_t;
constexpr float SSQ_SCALE = 16777216.0f;
__device__ __forceinline__ ssq_t ssq_fix(float sq) { return (ssq_t)(sq * SSQ_SCALE + 0.5f); }
#ifndef WT_AUX
#define WT_AUX 2
#endif
__device__ __forceinline__ float rstd_of(const ssq_t* ss, int row) { return rsqrtf((float)ss[row] * (1.0f / (2048.0f * SSQ_SCALE)) + EPS); }
__device__ __forceinline__ void row_pos(int row, int& b, int& s, int& S) { if (row < MP) { b = row >> 12; s = row & 4095; S = SEQ; } else { const int rr = row - MP; b = rr >> 6; s = rr & 63; S = DSEQ; } }

#define XB_TMO      128
#define XB_XCNT(j)  (256  + 64 * (j))
#define XB_XSUB(j)  (1280 + 64 * (j))
#define XB_XGEN(j)  (2304 + 64 * (j))
#define XB_TOP      3328
#define XB_TOPGEN   3392
#define XCD_BAR_WORDS 3456
#define XB_SPIN_CAP (1u << 18)
__device__ __forceinline__ unsigned xb_ld(unsigned* p)              { return __hip_atomic_load(p, __ATOMIC_RELAXED, __HIP_MEMORY_SCOPE_AGENT); }
__device__ __forceinline__ unsigned xb_add(unsigned* p, unsigned v) { return __hip_atomic_fetch_add(p, v, __ATOMIC_RELAXED, __HIP_MEMORY_SCOPE_AGENT); }
__device__ __forceinline__ unsigned xb_xcc_id() { return (unsigned)__builtin_amdgcn_s_getreg((3 << 11) | 20) & 0xFu; }
#define XB_SPIN(cond, bar) do { unsigned _sp = 0; while (cond) { __builtin_amdgcn_s_sleep(1); \
    if ((++_sp & 255u) == 0u) { if (xb_ld(&(bar)[XB_TMO])) break; if (_sp > XB_SPIN_CAP) { atomicAdd(&(bar)[XB_TMO], 1u); break; } } } } while (0)
struct XcdBarrier { unsigned* bar; unsigned x; volatile LAS unsigned* st; };
__device__ __forceinline__ XcdBarrier xcd_barrier_post(unsigned* bar, volatile LAS unsigned* st) {
    XcdBarrier b; b.bar = bar; b.x = xb_xcc_id(); b.st = st;
    if (threadIdx.x == 0) (void)xb_add(&bar[XB_XCNT(b.x)], 1u);
    return b;
}
__device__ __forceinline__ void xcd_barrier_complete(unsigned* bar, unsigned x, unsigned& nloc, unsigned& nx) {
    const unsigned G = gridDim.x * gridDim.y * gridDim.z;
    unsigned sum, cnt, mine, sp = 0u;
    for (;;) {
        sum = 0u; cnt = 0u; mine = 0u;
#pragma unroll
        for (unsigned j = 0; j < 16; ++j) { const unsigned c = xb_ld(&bar[XB_XCNT(j)]); sum += c; cnt += (c > 0u) ? 1u : 0u; mine = (j == x) ? c : mine; }
        if (sum == G) break;
        __builtin_amdgcn_s_sleep(1);
        if ((++sp & 255u) == 0u) { if (xb_ld(&bar[XB_TMO])) break; if (sp > XB_SPIN_CAP) { atomicAdd(&bar[XB_TMO], 1u); break; } }
    }
    nloc = mine > 0u ? mine : 1u; nx = cnt > 0u ? cnt : 1u;
}
__device__ __forceinline__ void xcd_barrier(const XcdBarrier& b, int wv) {
    asm volatile("s_waitcnt vmcnt(0)" ::: "memory");
    __syncthreads();
    if (fresh_tid(wv) == 0) {
        unsigned* bar = b.bar;
        __builtin_amdgcn_s_waitcnt(0);
        unsigned nloc = b.st[0], nx = b.st[1];
        if (nloc == 0u) { xcd_barrier_complete(bar, b.x, nloc, nx); b.st[0] = nloc; b.st[1] = nx; }
        const unsigned old = xb_add(&bar[XB_XSUB(b.x)], 1u);
        const unsigned gen = old / nloc;
        if (old + 1u == (gen + 1u) * nloc) {
            __builtin_amdgcn_fence(__ATOMIC_RELEASE, "agent");
            asm volatile("s_waitcnt vmcnt(0)" ::: "memory");
            const unsigned og = xb_add(&bar[XB_TOP], 1u);
            const unsigned tg = og / nx;
            if (og + 1u == (tg + 1u) * nx) xb_add(&bar[XB_TOPGEN], 1u);
            else XB_SPIN(xb_ld(&bar[XB_TOPGEN]) == tg, bar);
            __builtin_amdgcn_fence(__ATOMIC_ACQUIRE, "agent");
            xb_add(&bar[XB_XGEN(b.x)], 1u);
            asm volatile("s_waitcnt vmcnt(0)" ::: "memory");
        } else {
            XB_SPIN(xb_ld(&bar[XB_XGEN(b.x)]) == gen, bar);
            __builtin_amdgcn_fence(__ATOMIC_ACQUIRE, "agent");
            asm volatile("s_waitcnt vmcnt(0)" ::: "memory");
        }
    }
    __syncthreads();
}
namespace pg8 {
constexpr int BM = 256, BK = 64, HALF = 128, HTB = HALF * BK * 2, STAGE_BYTES = 8 * HTB, NXCD = 8, WGM = 8;
__host__ __device__ __forceinline__ int lds_byte(int r, int c) { const int st = (r >> 4) * 2 + (c >> 5), rr = r & 15, cc = c & 31, ob = rr * 64 + cc * 2; return st * 1024 + (ob ^ (((ob >> 9) & 1) << 5)); }
__host__ __device__ __forceinline__ void stage_rc(int b, int& R, int& C) { const int st = b / 1024, sb = b % 1024, swz = sb ^ (((sb >> 9) & 1) << 5); R = (st >> 1) * 16 + swz / 64; C = (st & 1) * 32 + (swz % 64) / 2; }
__host__ __device__ __forceinline__ int perm32(int rho) { const int n = rho >> 4, i = rho & 15; return 8 * (i >> 2) + 4 * n + (i & 3); }
struct Unit { int pm, pn, k0, nt, part; };
struct Gemm { const bf16_t* A; const bf16_t* Bt; int M, N, K; int amul = 1, bmul = 1; };
struct StaticOrder {
    int nM, nN, nwg, G, c, KT, nreg;
    __device__ __forceinline__ void init(int M, int N, int K, int G_, int c_, bool tail) { nM = M / BM; nN = N / BM; nwg = nM * nN; G = G_; c = c_; KT = K / BK; nreg = nwg;
        if (tail) { const int rem = nwg % G; if (rem > 0 && rem * 8 == G && (KT / 8) >= 4) nreg = nwg - rem; } }
    __device__ __forceinline__ int map(int L) const {
        int wgid = L; { const int q = nwg / NXCD, r = nwg % NXCD, xcd = wgid % NXCD, off = wgid / NXCD; wgid = (xcd < r ? xcd * (q + 1) : r * (q + 1) + (xcd - r) * q) + off; }
        const int nig = WGM * nN, gid = wgid / nig, fm = gid * WGM, gsz = (nM - fm) < WGM ? (nM - fm) : WGM;
        return ((fm + ((wgid % nig) % gsz)) << 16) | ((wgid % nig) / gsz);
    }
    __device__ __forceinline__ bool next(int i, Unit& u) const {
        const long L = (long)i * G + c;
        const bool reg = L < nreg, tl = !reg && nreg < nwg && i == nreg / G;
        const int j = c >> 3, s = c & 7, q = KT >> 3;
        const int pq = map(reg ? (int)L : (tl ? nreg + j : 0));
        const int nt_t = (q & 1) ? ((s & 1) ? q - 1 : q + 1) : q, k0_t = ((q & 1) ? (s * q + (s & 1)) : s * q) * BK;
        u.pm = pq >> 16; u.pn = pq & 0xffff; u.k0 = reg ? 0 : k0_t; u.nt = reg ? KT : nt_t; u.part = reg ? -1 : j * 8 + s;
        return reg || tl;
    }
};
template <class Epi>
__device__ __forceinline__ void gemm_phase(LAS unsigned char* lds, const Gemm g, const StaticOrder& S, const Epi& E, int wv, float* PART = nullptr) {
    const int tid = fresh_tid(wv), wid = __builtin_amdgcn_readfirstlane(tid >> 6), lane = tid & 63, wr = wid >> 2, wc = wid & 3, fr = lane & 15, fq = lane >> 4;
    const int K = g.K;
    unsigned voffA[2], voffB[2];
#pragma unroll
    for (int i = 0; i < 2; ++i) { int R, C; stage_rc(tid * 16 + i * 8192, R, C); const int Rb = ((R & ~31) + perm32(R & 31));
        voffA[i] = (unsigned)(R * K + C) * 2u; voffB[i] = (unsigned)(Rb * K + C) * 2u; }
    const size_t kstep = (size_t)(BK * 2);
    const size_t hstep = (size_t)HALF * K * 2;
    const size_t tstep = 2 * hstep;
    const unsigned ldsw = (unsigned)wid * 1024u;
    const int aoff = lds_byte(wr * 64 + fr, fq * 8), boff = lds_byte(wc * 32 + fr, fq * 8);
#define PG8_SA(b, h) (((b) * 2 + (h)) * HTB)
#define PG8_SB(b, h) ((4 + (b) * 2 + (h)) * HTB)
#define PG8_STAGE(bufoff, gbase, voff) do { _Pragma("unroll") for (int _i = 0; _i < 2; ++_i) \
        __builtin_amdgcn_global_load_lds((const unsigned*)((const char*)(gbase) + (voff)[_i]), (LAS unsigned*)(lds + (bufoff) + ldsw + _i * 8192), 16, 0, 0); } while (0)
#define PG8_LDA(dst, b, h) do { _Pragma("unroll") for (int m = 0; m < 4; ++m) _Pragma("unroll") for (int k = 0; k < 2; ++k) dst[m][k] = *(const LAS bf16x8*)(lds + PG8_SA(b, h) + aoff + m * 2048 + k * 1024); } while (0)
#define PG8_LDB(dst, b, h) do { _Pragma("unroll") for (int n = 0; n < 2; ++n) _Pragma("unroll") for (int k = 0; k < 2; ++k) dst[n][k] = *(const LAS bf16x8*)(lds + PG8_SB(b, h) + boff + n * 2048 + k * 1024); } while (0)
#define PG8_MMA(ai, bj, At, Bt) do { __builtin_amdgcn_s_setprio(1); _Pragma("unroll") for (int m = 0; m < 4; ++m) _Pragma("unroll") for (int n = 0; n < 2; ++n) _Pragma("unroll") for (int k = 0; k < 2; ++k) \
        acc[ai][bj][m][n] = __builtin_amdgcn_mfma_f32_16x16x32_bf16(Bt[n][k], At[m][k], acc[ai][bj][m][n], 0, 0, 0); __builtin_amdgcn_s_setprio(0); } while (0)
#define PG8_WAIT_V(n) asm volatile("s_waitcnt vmcnt(" #n ")" ::: "memory")
#define PG8_WAIT_L(n) asm volatile("s_waitcnt lgkmcnt(" #n ")" ::: "memory")
#define PG8_BAR __builtin_amdgcn_s_barrier()
#define PG8_SCHED __builtin_amdgcn_sched_barrier(0)
    Unit cur, nxt; int ui = 0;
    if (!S.next(0, cur)) return;
    f32x4 acc[2][2][4][2];
#pragma unroll
    for (int a = 0; a < 2; ++a)
#pragma unroll
        for (int b = 0; b < 2; ++b)
#pragma unroll
            for (int m = 0; m < 4; ++m)
#pragma unroll
                for (int n = 0; n < 2; ++n) acc[a][b][m][n] = (f32x4){0.f, 0.f, 0.f, 0.f};
    bf16x8 At[4][2], B0[2][2], B1[2][2];
    const char* cA = (const char*)g.A + (size_t)(cur.pm * g.amul) * tstep + (size_t)cur.k0 * 2; const char* cB = (const char*)g.Bt + (size_t)(cur.pn * g.bmul) * tstep + (size_t)cur.k0 * 2;
    int nt = cur.nt;
#ifdef PG8_OLD
    PG8_STAGE(PG8_SB(0, 0), cB, voffB); PG8_STAGE(PG8_SA(0, 0), cA, voffA); PG8_STAGE(PG8_SB(0, 1), cB + hstep, voffB); PG8_STAGE(PG8_SA(0, 1), cA + hstep, voffA);
    if (wr == 1) PG8_BAR;
    PG8_WAIT_V(4); PG8_BAR;
    PG8_STAGE(PG8_SB(1, 0), cB + kstep, voffB); PG8_STAGE(PG8_SA(1, 0), cA + kstep, voffA); PG8_STAGE(PG8_SB(1, 1), cB + hstep + kstep, voffB);
    PG8_WAIT_V(6); PG8_BAR;
#else
    PG8_STAGE(PG8_SB(0, 0), cB, voffB); PG8_STAGE(PG8_SB(0, 1), cB + hstep, voffB); PG8_STAGE(PG8_SA(0, 0), cA, voffA); PG8_STAGE(PG8_SA(0, 1), cA + hstep, voffA);
    if (wr == 1) PG8_BAR;
    PG8_WAIT_V(2); PG8_BAR;
    PG8_STAGE(PG8_SB(1, 0), cB + kstep, voffB); PG8_STAGE(PG8_SA(1, 0), cA + kstep, voffA); PG8_STAGE(PG8_SB(1, 1), cB + hstep + kstep, voffB);
    PG8_WAIT_V(6); PG8_BAR;
#endif
    for (;;) {
        const bool has_next = S.next(ui + 1, nxt);
        const char* nA = has_next ? (const char*)g.A + (size_t)(nxt.pm * g.amul) * tstep + (size_t)nxt.k0 * 2 : cA; const char* nB = has_next ? (const char*)g.Bt + (size_t)(nxt.pn * g.bmul) * tstep + (size_t)nxt.k0 * 2 : cB;
        for (int t = 0; t < nt; t += 2) {
            const bool last = (t == nt - 2);
            const char* a1 = cA + (size_t)(t + 1) * kstep;
            const char* a2 = last ? nA : cA + (size_t)(t + 2) * kstep; const char* b2 = last ? nB : cB + (size_t)(t + 2) * kstep;
            const char* a3 = a2 + kstep; const char* b3 = b2 + kstep;
#ifdef PG8_OLD
            PG8_LDB(B0, 0, 0); PG8_SCHED; PG8_LDA(At, 0, 0); PG8_STAGE(PG8_SA(1, 1), a1 + hstep, voffA);
            PG8_WAIT_L(8); PG8_BAR; PG8_WAIT_L(0); PG8_MMA(0, 0, At, B0); PG8_BAR; PG8_SCHED;
            PG8_LDB(B1, 0, 1); PG8_STAGE(PG8_SB(0, 0), b2, voffB);
            PG8_BAR; PG8_WAIT_L(0); PG8_MMA(0, 1, At, B1); PG8_BAR;
            PG8_LDA(At, 0, 1); PG8_STAGE(PG8_SA(0, 0), a2, voffA);
            PG8_BAR; PG8_WAIT_L(0); PG8_MMA(1, 0, At, B0); PG8_BAR; PG8_SCHED;
            PG8_STAGE(PG8_SB(0, 1), b2 + hstep, voffB);
            PG8_WAIT_V(6); PG8_BAR; PG8_MMA(1, 1, At, B1); PG8_BAR;
            PG8_LDB(B0, 1, 0); PG8_SCHED; PG8_LDA(At, 1, 0); PG8_STAGE(PG8_SA(0, 1), a2 + hstep, voffA);
            PG8_WAIT_L(8); PG8_BAR; PG8_WAIT_L(0); PG8_MMA(0, 0, At, B0); PG8_BAR; PG8_SCHED;
            PG8_LDB(B1, 1, 1); PG8_STAGE(PG8_SB(1, 0), b3, voffB);
            PG8_BAR; PG8_WAIT_L(0); PG8_MMA(0, 1, At, B1); PG8_BAR;
            PG8_LDA(At, 1, 1); PG8_STAGE(PG8_SA(1, 0), a3, voffA);
            PG8_BAR; PG8_WAIT_L(0); PG8_MMA(1, 0, At, B0); PG8_BAR; PG8_SCHED;
            PG8_STAGE(PG8_SB(1, 1), b3 + hstep, voffB);
            PG8_WAIT_V(6); PG8_BAR; PG8_MMA(1, 1, At, B1); PG8_BAR;
#else
            PG8_LDB(B0, 0, 0); PG8_LDB(B1, 0, 1); PG8_SCHED; PG8_LDA(At, 0, 0); PG8_STAGE(PG8_SA(1, 1), a1 + hstep, voffA);
            PG8_WAIT_V(8);
            PG8_WAIT_L(0); PG8_BAR; PG8_MMA(0, 0, At, B0); PG8_MMA(0, 1, At, B1); PG8_BAR; PG8_SCHED;
            PG8_LDA(At, 0, 1); PG8_STAGE(PG8_SB(0, 0), b2, voffB); PG8_STAGE(PG8_SB(0, 1), b2 + hstep, voffB); PG8_STAGE(PG8_SA(0, 0), a2, voffA);
            PG8_WAIT_V(8);
            PG8_WAIT_L(0); PG8_BAR; PG8_MMA(1, 0, At, B0); PG8_MMA(1, 1, At, B1); PG8_BAR; PG8_SCHED;
            PG8_LDB(B0, 1, 0); PG8_LDB(B1, 1, 1); PG8_SCHED; PG8_LDA(At, 1, 0); PG8_STAGE(PG8_SA(0, 1), a2 + hstep, voffA);
            PG8_WAIT_V(8); PG8_WAIT_L(0); PG8_BAR; PG8_MMA(0, 0, At, B0); PG8_MMA(0, 1, At, B1); PG8_BAR; PG8_SCHED;
            PG8_LDA(At, 1, 1); PG8_STAGE(PG8_SB(1, 0), b3, voffB); PG8_STAGE(PG8_SB(1, 1), b3 + hstep, voffB); PG8_STAGE(PG8_SA(1, 0), a3, voffA);
            PG8_WAIT_V(8); PG8_WAIT_L(0); PG8_BAR; PG8_MMA(1, 0, At, B0); PG8_MMA(1, 1, At, B1); PG8_BAR; PG8_SCHED;
#endif
        }
#ifndef PG8_OLD
        if (wr == 0) PG8_BAR;
#endif
        if (cur.part >= 0) {
            float* pt = PART + (size_t)cur.part * 65536 + (size_t)(wr * 64 + fr) * 256 + wc * 32 + 8 * fq;
#pragma unroll
            for (int ai = 0; ai < 2; ++ai)
#pragma unroll
                for (int m = 0; m < 4; ++m)
#pragma unroll
                    for (int bj = 0; bj < 2; ++bj) { float* q = pt + (size_t)(ai * 128 + m * 16) * 256 + bj * 128; *(f32x4*)q = acc[ai][bj][m][0]; *(f32x4*)(q + 4) = acc[ai][bj][m][1]; }
        } else E(acc, cur, wr, wc, fr, fq);
        if (!has_next) break;
#pragma unroll
        for (int a = 0; a < 2; ++a)
#pragma unroll
            for (int b = 0; b < 2; ++b)
#pragma unroll
                for (int m = 0; m < 4; ++m)
#pragma unroll
                    for (int n = 0; n < 2; ++n) acc[a][b][m][n] = (f32x4){0.f, 0.f, 0.f, 0.f};
        cur = nxt; cA = nA; cB = nB; nt = cur.nt; ++ui;
#ifndef PG8_OLD
        if (wr == 1) PG8_BAR;
#endif
    }
    PG8_WAIT_V(0);
#ifdef PG8_OLD
    if (wr == 0) PG8_BAR;
#endif
    PG8_BAR;
#undef PG8_SA
#undef PG8_SB
#undef PG8_STAGE
#undef PG8_LDA
#undef PG8_LDB
#undef PG8_MMA
#undef PG8_WAIT_V
#undef PG8_WAIT_L
#undef PG8_BAR
#undef PG8_SCHED
}
}
using pg8::Unit;

typedef f32x4 Acc[2][2][4][2];
#define EPI_ROWS(...) _Pragma("unroll") for (int ai = 0; ai < 2; ++ai) _Pragma("unroll") for (int m = 0; m < 4; ++m) { const int row = u.pm * 256 + ai * 128 + wr * 64 + m * 16 + fr; __VA_ARGS__ }
__device__ __forceinline__ u32x4 pack8(const f32x4 a, const f32x4 b) { u32x4 w; w.x = cvt_pk_bf16(a[0], a[1]); w.y = cvt_pk_bf16(a[2], a[3]); w.z = cvt_pk_bf16(b[0], b[1]); w.w = cvt_pk_bf16(b[2], b[3]); return w; }

struct EpiRowScale {
    static constexpr int MINST = 16;
    const ssq_t* ss; bf16_t* O0; int ld0; int split; bf16_t* O1; int ld1; int nstate; int state_cols; float* st_p; float* st_s; bf16_t* halo;
    __device__ __forceinline__ void operator()(Acc& acc, const Unit& u, int wr, int wc, int fr, int fq) const {
        int colt = u.pn * 256; bf16_t* base = O0; int ld = ld0; const int gcol0 = colt + wc * 32 + 8 * fq; const bool halo_tile = halo != nullptr && colt < 4096;
        if (colt >= split) { base = O1; ld = ld1; colt -= split; }
        const int col0 = colt + wc * 32 + 8 * fq;
        const bool st_tile = nstate > 0 && (u.pn * 256 < state_cols);
        EPI_ROWS(
            const float rs = ss ? rstd_of(ss, row) : 1.0f;
            bf16_t* rowp = base + (size_t)row * ld + col0;
            _Pragma("unroll") for (int bj = 0; bj < 2; ++bj) *(u32x4*)(rowp + bj * 128) = pack8(acc[ai][bj][m][0] * rs, acc[ai][bj][m][1] * rs);
            if (halo_tile && (row & 63) >= 61) { bf16_t* hp = halo + ((size_t)(row >> 6) * 3 + ((row & 63) - 61)) * 4096 + gcol0;
                _Pragma("unroll") for (int bj = 0; bj < 2; ++bj) *(u32x4*)(hp + bj * 128) = pack8(acc[ai][bj][m][0] * rs, acc[ai][bj][m][1] * rs); }
            if (st_tile) { int b, s, S; row_pos(row, b, s, S); const int j = s - (S - nstate);
                if (j >= 0) { float* dst = (row < MP ? st_p : st_s) + ((size_t)b * nstate + j) * state_cols + gcol0;
                    _Pragma("unroll") for (int bj = 0; bj < 2; ++bj) { *(f32x4*)(dst + bj * 128) = acc[ai][bj][m][0] * rs; *(f32x4*)(dst + bj * 128 + 4) = acc[ai][bj][m][1] * rs; } } }
        )
    }
};
struct EpiA1 {
    static constexpr int MINST = 16;
    const ssq_t* ss; bf16_t* BG; bf16_t* CV; float* st_p; float* st_s;
    __device__ __forceinline__ void operator()(Acc& acc, const Unit& u, int wr, int wc, int fr, int fq) const {
        if (u.pn < 8) {
            const int col0 = u.pn * 256 + wc * 32 + 8 * fq;
            EPI_ROWS(
                const float rs = rstd_of(ss, row); bf16_t* rowp = BG + (size_t)row * DM + col0;
                _Pragma("unroll") for (int bj = 0; bj < 2; ++bj) *(u32x4*)(rowp + bj * 128) = pack8(acc[ai][bj][m][0] * rs, acc[ai][bj][m][1] * rs);
            )
        } else {
            const int ch0 = (u.pn - 8) * 128 + wc * 32 + 8 * fq;
            EPI_ROWS(
                const float rs = rstd_of(ss, row); const float rs2 = rs * rs;
                const f32x4 c0 = acc[ai][0][m][0] * acc[ai][1][m][0] * rs2, c1 = acc[ai][0][m][1] * acc[ai][1][m][1] * rs2;
                *(u32x4*)(CV + (size_t)row * DM + ch0) = pack8(c0, c1);
                int b, s, S; row_pos(row, b, s, S); const int j = s - (S - 2);
                if (j >= 0) { float* dst = (row < MP ? st_p : st_s) + ((size_t)b * 2 + j) * DM + ch0; *(f32x4*)dst = c0; *(f32x4*)(dst + 4) = c1; }
            )
        }
    }
};
#ifndef RES16
#define RES16 1
#endif
template <bool PLEGATE> struct EpiResid {
    static constexpr int MINST = 16;
    float* H; const bf16_t* HBI; bf16_t* HB; ssq_t* ssn; const ssq_t* ssc; const bf16_t* PPB;
    __device__ __forceinline__ void operator()(Acc& acc, const Unit& u, int wr, int wc, int fr, int fq) const {
        const int col0 = u.pn * 256 + wc * 32 + 8 * fq;
        EPI_ROWS(
            float rs = 1.0f; if (PLEGATE) rs = rstd_of(ssc, row);
            float sq = 0.f;
            _Pragma("unroll") for (int bj = 0; bj < 2; ++bj) {
                const size_t off = (size_t)row * DM + col0 + bj * 128;
                f32x4 h0; f32x4 h1;
                if (RES16) { const u32x4 hw = *(const u32x4*)(HBI + off); h0 = (f32x4){bflo(hw.x), bfhi(hw.x), bflo(hw.y), bfhi(hw.y)}; h1 = (f32x4){bflo(hw.z), bfhi(hw.z), bflo(hw.w), bfhi(hw.w)}; }
                else { h0 = *(const f32x4*)(H + off); h1 = *(const f32x4*)(H + off + 4); }
                f32x4 a0 = acc[ai][bj][m][0], a1 = acc[ai][bj][m][1];
                if (PLEGATE) {
                    const u32x4 pw = *(const u32x4*)(PPB + off);
                    const f32x4 p0 = (f32x4){bflo(pw.x), bfhi(pw.x), bflo(pw.y), bfhi(pw.y)}, p1 = (f32x4){bflo(pw.z), bfhi(pw.z), bflo(pw.w), bfhi(pw.w)};
                    _Pragma("unroll") for (int e = 0; e < 4; ++e) { a0[e] = p0[e] * sigmoidf_(a0[e] * rs); a1[e] = p1[e] * sigmoidf_(a1[e] * rs); }
                }
                h0 += a0; h1 += a1;
                if (!RES16) { *(f32x4*)(H + off) = h0; *(f32x4*)(H + off + 4) = h1; }
                *(u32x4*)(HB + off) = pack8(h0, h1);
                sq += (h0[0] * h0[0] + h0[1] * h0[1]) + (h0[2] * h0[2] + h0[3] * h0[3]) + (h1[0] * h1[0] + h1[1] * h1[1]) + (h1[2] * h1[2] + h1[3] * h1[3]);
            }
            sq += __shfl_xor(sq, 16); sq += __shfl_xor(sq, 32);
            if (fq == 0) atomicAdd(ssn + row, ssq_fix(sq));
        )
    }
};

#ifdef DPP_FLIP
#define DPP_R1 0x12F
#define DPP_R2 0x12E
#else
#define DPP_R1 0x121
#define DPP_R2 0x122
#endif
__device__ __forceinline__ float dpp_ror1(float v) { return __int_as_float(__builtin_amdgcn_update_dpp(0, __float_as_int(v), DPP_R1, 0xf, 0xf, false)); }
__device__ __forceinline__ float dpp_ror2(float v) { return __int_as_float(__builtin_amdgcn_update_dpp(0, __float_as_int(v), DPP_R2, 0xf, 0xf, false)); }
struct EpiGlu {
    static constexpr int MINST = 16;
    const ssq_t* ss; bf16_t* ACT; float* XB; const float* wc; const float* bc; float* st_p; float* st_s;
    __device__ __forceinline__ void operator()(Acc& acc, const Unit& u, int wr, int wc_, int fr, int fq) const {
        const int j0 = u.pn * 128 + wc_ * 32 + 8 * fq;
#pragma unroll
        for (int ai = 0; ai < 2; ++ai)
#pragma unroll
            for (int m = 0; m < 4; ++m) { const float rs = rstd_of(ss, u.pm * 256 + ai * 128 + wr * 64 + m * 16 + fr);
#pragma unroll
                for (int bj = 0; bj < 2; ++bj) { acc[ai][bj][m][0] *= rs; acc[ai][bj][m][1] *= rs; } }
#pragma unroll
        for (int n = 0; n < 2; ++n) {
            const int jc = j0 + 4 * n;
            f32x4 wg[3], wu[3];
#pragma unroll
            for (int d = 0; d < 3; ++d) { wg[d] = *(const f32x4*)(wc + d * DFF2 + jc); wu[d] = *(const f32x4*)(wc + d * DFF2 + DFF + jc); }
            const f32x4 bg = *(const f32x4*)(bc + jc), bu = *(const f32x4*)(bc + DFF + jc);
#pragma unroll
            for (int ai = 0; ai < 2; ++ai) {
#pragma unroll
                for (int m = 0; m < 4; ++m) {
                    const int row = u.pm * 256 + ai * 128 + wr * 64 + m * 16 + fr, r64 = m * 16 + fr;
                    const f32x4 cg = acc[ai][0][m][n], cu = acc[ai][1][m][n];
                    const f32x4 pg = acc[ai][0][m > 0 ? m - 1 : 0][n], pu = acc[ai][1][m > 0 ? m - 1 : 0][n];
                    f32x4 g1, g2, u1, u2;
#pragma unroll
                    for (int e = 0; e < 4; ++e) {
                        g1[e] = DPPF(dpp_ror1(pg[e]), cg[e], 0x111, 0xf); g2[e] = DPPF(dpp_ror2(pg[e]), cg[e], 0x112, 0xf);
                        u1[e] = DPPF(dpp_ror1(pu[e]), cu[e], 0x111, 0xf); u2[e] = DPPF(dpp_ror2(pu[e]), cu[e], 0x112, 0xf);
                    }
                    const f32x4 ug = wg[0] * g2 + wg[1] * g1 + wg[2] * cg + bg, uu = wu[0] * u2 + wu[1] * u1 + wu[2] * cu + bu;
                    f32x4 o;
#pragma unroll
                    for (int e = 0; e < 4; ++e) o[e] = siluf_(ug[e]) * uu[e];
                    if (r64 >= 2) { u32x2 w; w.x = cvt_pk_bf16(o[0], o[1]); w.y = cvt_pk_bf16(o[2], o[3]); *(u32x2*)(ACT + (size_t)row * DFF + jc) = w; }
                    if (r64 < 2 || r64 >= 62) {
                        float* xb = XB + ((size_t)(row >> 6) * 4 + ((r64 + 2) & 3)) * DFF2 + jc;
                        *(f32x4*)xb = cg; *(f32x4*)(xb + DFF) = cu;
                        if (r64 >= 62) { int b, s, S; row_pos(row, b, s, S);
                            if (s >= S - 2) { float* dst = (row < MP ? st_p : st_s) + ((size_t)b * 2 + (s - (S - 2))) * DFF2 + jc; *(f32x4*)dst = cg; *(f32x4*)(dst + DFF) = cu; } }
                    }
                }
            }
        }
    }
};
struct EpiNull { static constexpr int MINST = 0; __device__ __forceinline__ void operator()(Acc& acc, const Unit& u, int wr, int wc, int fr, int fq) const { asm volatile("" :: "v"(acc[0][0][0][0][0])); } };
struct EpiPlain {
    static constexpr int MINST = 16;
    bf16_t* O; int ld;
    __device__ __forceinline__ void operator()(Acc& acc, const Unit& u, int wr, int wc, int fr, int fq) const {
        const int col0 = u.pn * 256 + wc * 32 + 8 * fq;
        EPI_ROWS(
            bf16_t* rowp = O + (size_t)row * ld + col0;
            _Pragma("unroll") for (int bj = 0; bj < 2; ++bj) *(u32x4*)(rowp + bj * 128) = pack8(acc[ai][bj][m][0], acc[ai][bj][m][1]);
        )
    }
};
__device__ __forceinline__ int src_col(int cmap, int col_off, int n) {
    if (cmap == 1) { if (n < 2048) return n; const int t = (n - 2048) >> 8, w = (n - 2048) & 255; return w < 128 ? 2048 + 128 * t + w : 4096 + 128 * t + (w - 128); }
    if (cmap == 2) { const int t = n >> 8, w = n & 255; return w < 128 ? 128 * t + w : DFF + 128 * t + (w - 128); }
    return col_off + n;
}
__device__ __forceinline__ void prep_matrix(int wv, LAS float* tile, const float* W, int ldw, int K, int nrows, bf16_t* dst, const float* gain, int cmap, int col_off, int& tctr, const int G, const int c, const int row0 = 0) {
    const int tid = fresh_tid(wv);
    if (nrows >= 128) {
        const int ktiles = K >> 7, ntiles = nrows >> 7, total = ktiles * ntiles;
        int t = (int)((c + G - (tctr % G)) % G);
        const int lane = tid & 63, wid = tid >> 6, ks = (wid >> 2) * 64 + 8 * (lane >> 3), ns = (wid & 3) * 32 + 4 * (lane & 7);
        const __amdgpu_buffer_rsrc_t drs = __builtin_amdgcn_make_buffer_rsrc((void*)dst, 0, 0x7fffffff, 0x00020000);
        f32x4 v[8];
#define PREP_LOAD(tt) do { const int nt_ = (tt) / ktiles, kt_ = (tt) % ktiles; const float* src_ = W + (size_t)(kt_ * 128 + ks) * ldw + src_col(cmap, col_off, row0 + nt_ * 128) + ns; \
            _Pragma("unroll") for (int p = 0; p < 8; ++p) v[p] = __builtin_nontemporal_load((const f32x4*)(src_ + (size_t)p * ldw)); } while (0)
        if (t < total) PREP_LOAD(t);
        for (; t < total; t += G) {
            const int nt = t / ktiles, kt = t % ktiles, n0 = nt * 128, k0 = kt * 128;
            f32x4 g0 = {1.f, 1.f, 1.f, 1.f}, g1 = g0; if (gain) { g0 = *(const f32x4*)(gain + k0 + ks); g1 = *(const f32x4*)(gain + k0 + ks + 4); }
            u32x4 w[4];
#pragma unroll
            for (int e = 0; e < 4; ++e) { w[e].x = cvt_pk_bf16(v[0][e] * g0[0], v[1][e] * g0[1]); w[e].y = cvt_pk_bf16(v[2][e] * g0[2], v[3][e] * g0[3]);
                w[e].z = cvt_pk_bf16(v[4][e] * g1[0], v[5][e] * g1[1]); w[e].w = cvt_pk_bf16(v[6][e] * g1[2], v[7][e] * g1[3]); }
            if (t + G < total) PREP_LOAD(t + G);
            const unsigned d_ = (unsigned)(((size_t)(row0 + n0 + ns) * K + k0 + ks) * 2);
#pragma unroll
            for (int e = 0; e < 4; ++e) __builtin_amdgcn_raw_buffer_store_b128(w[e], drs, (int)(d_ + (unsigned)e * (unsigned)K * 2u), 0, WT_AUX);
        }
#undef PREP_LOAD
        tctr += total;
    } else {
        const int ktiles = K >> 6, ntiles = nrows >> 6, total = ktiles * ntiles;
        int t = (int)((c + G - (tctr % G)) % G);
        for (; t < total; t += G) {
            const int nt = t / ktiles, kt = t % ktiles, n0 = nt * 64, k0 = kt * 64, ns0 = src_col(cmap, col_off, n0);
            const int ty = tid >> 4, tx = tid & 15;
#pragma unroll
            for (int p = 0; p < 2; ++p) { const int k = k0 + ty + 32 * p; const f32x4 v = *(const f32x4*)(W + (size_t)k * ldw + ns0 + 4 * tx); const float g = gain ? gain[k] : 1.0f;
#pragma unroll
                for (int e = 0; e < 4; ++e) tile[(4 * tx + e) * 129 + ty + 32 * p] = v[e] * g; }
            __syncthreads();
            { const int n = tid >> 3, kg = tid & 7; const LAS float* src = tile + n * 129 + 8 * kg;
              u32x4 w; w.x = cvt_pk_bf16(src[0], src[1]); w.y = cvt_pk_bf16(src[2], src[3]); w.z = cvt_pk_bf16(src[4], src[5]); w.w = cvt_pk_bf16(src[6], src[7]);
              *(u32x4*)(dst + (size_t)(n0 + n) * K + k0 + 8 * kg) = w; }
            __syncthreads();
        }
        tctr += total;
    }
}
#ifndef JOBSITES
#define JOBSITES 0, 1, 6, 6, 0, 0, 3, 0, 5,  1, 1, 1, 1, 1, 1, 0,  2, 2, 2, 3, 4, 4, 0,  5, 5, 5, 5, 5, 5, 0,  7, 7, 7, 7, 8, 7, 0
#endif
constexpr int job_site(int j) { constexpr int t[37] = {JOBSITES}; return t[j]; }
#ifndef JOBSITES2
#define JOBSITES2 0
#endif
constexpr bool job_in(int j, int site) { constexpr int t2[37] = {JOBSITES2}; return site == 99 ? t2[j] == 1 : job_site(j) == site; }
template <int SITE>
__device__ __forceinline__ void prep_jobs(const Params& P, int wv, LAS unsigned char* lds, const int G, const int c) {
    unsigned char* ws = P.ws; asm volatile("" : "+s"(ws)); LAS float* tile = (LAS float*)lds; int tctr = 0;
#define JOB(j, ...) if (job_in(j, SITE)) prep_matrix(wv, tile, __VA_ARGS__, tctr, G, c);
    JOB(0, P.in[I_WAIN], 6144, 2048, 6144, (bf16_t*)(ws + WS_WAIN), P.in[I_GMIX], 1, 0)
    JOB(1, P.in[I_WAOUT], 2048, 2048, 2048, (bf16_t*)(ws + WS_WAOUT), nullptr, 0, 0)
    JOB(2, P.in[I_WAIN] + (size_t)2048 * 6144, 6144, 2048, 6144, (bf16_t*)(ws + WS_WAIN) + (size_t)6144 * 2048, P.in[I_GMIX] + 3 * 2048, 1, 0)
    JOB(3, P.in[I_WAOUT] + (size_t)2048 * 2048, 2048, 2048, 2048, (bf16_t*)(ws + WS_WAOUT) + (size_t)2048 * 2048, nullptr, 0, 0)
    JOB(4, P.in[I_WBIN], DNIN, 2048, 12288, (bf16_t*)(ws + WS_WBIN), P.in[I_GMIX] + 1 * 2048, 0, 0)
    JOB(5, P.in[I_WBIN], DNIN, 2048, 64, (bf16_t*)(ws + WS_WBBA), P.in[I_GMIX] + 1 * 2048, 0, 12288)
    JOB(6, P.in[I_WBOUT], 2048, 4096, 2048, (bf16_t*)(ws + WS_WBOUT), nullptr, 0, 0)
    JOB(7, P.in[I_WCQKV], 6144, 2048, 6144, (bf16_t*)(ws + WS_WCQKV), P.in[I_GMIX] + 2 * 2048, 0, 0)
    JOB(8, P.in[I_WCOUT], 2048, 2048, 2048, (bf16_t*)(ws + WS_WCOUT), nullptr, 0, 0)
#define JOB_FUP(i, q) if (job_in(9 + 7 * i + q, SITE)) prep_matrix(wv, tile, P.in[I_WFUP] + (size_t)i * 2048 * DFF2, DFF2, 2048, DFF2 / 4, (bf16_t*)(ws + WS_WFUP) + (size_t)i * DFF2 * 2048, P.in[I_GFFN] + i * 2048, 2, 0, tctr, G, c, q * (DFF2 / 4));
#define JOBS_FFN(i) JOB_FUP(i, 0) JOB_FUP(i, 1) JOB_FUP(i, 2) JOB_FUP(i, 3) \
    JOB(13 + 7 * i, P.in[I_WFDOWN] + (size_t)i * DFF * 2048, 2048, DFF, 2048, (bf16_t*)(ws + WS_WFDOWN) + (size_t)i * 2048 * DFF, nullptr, 0, 0) \
    JOB(14 + 7 * i, P.in[I_WPG] + (size_t)i * 2048 * 2048, 2048, 2048, 2048, (bf16_t*)(ws + WS_WPG) + (size_t)i * 2048 * 2048, P.in[I_GPLE] + i * 2048, 0, 0) \
    JOB(15 + 7 * i, P.in[I_WPP] + (size_t)i * PLE * 2048, 2048, PLE, 2048, (bf16_t*)(ws + WS_WPP) + (size_t)i * 2048 * PLE, nullptr, 0, 0)
    JOBS_FFN(0) JOBS_FFN(1) JOBS_FFN(2) JOBS_FFN(3)
#undef JOBS_FFN
#undef JOB_FUP
#undef JOB
}
template <int SITE>
__device__ __forceinline__ void prep_fill(const Params& P, int wv, LAS unsigned char* lds, int nunits, int G, int wg) {
    const int rem = nunits % G, G2 = rem ? G - rem : G, c2 = rem ? wg - rem : wg;
    if (c2 >= 0) prep_jobs<SITE>(P, wv, lds, G2, c2);
}
__device__ __forceinline__ void phase_prologue(const Params& P, int wv, LAS unsigned char* lds) {
    unsigned char* ws = P.ws;
    prep_jobs<0>(P, wv, lds, (int)gridDim.x, (int)blockIdx.x);
    const int tid_ = fresh_tid(wv), lane = tid_ & 63, gw = blockIdx.x * 8 + (tid_ >> 6), nw = gridDim.x * 8;
    float* H = (float*)(ws + WS_H); bf16_t* HB = (bf16_t*)(ws + WS_HB); ssq_t* SS0 = (ssq_t*)(ws + WS_SS);
    for (int row = gw; row < MT; row += nw) {
        const float* src = row < MP ? P.in[I_XP] + (size_t)row * DM : P.in[I_XS] + (size_t)(row - MP) * DM;
        float sq = 0.f;
#pragma unroll
        for (int j = 0; j < 4; ++j) {
            const int c = (j * 64 + lane) * 8;
            const f32x4 a = *(const f32x4*)(src + c), b = *(const f32x4*)(src + c + 4);
            if (!RES16) { *(f32x4*)(H + (size_t)row * DM + c) = a; *(f32x4*)(H + (size_t)row * DM + c + 4) = b; }
            *(u32x4*)(HB + (size_t)row * DM + c) = pack8(a, b);
            sq += (a[0] * a[0] + a[1] * a[1]) + (a[2] * a[2] + a[3] * a[3]) + (b[0] * b[0] + b[1] * b[1]) + (b[2] * b[2] + b[3] * b[3]);
        }
        sq = wave_sum(sq);
        if (lane == 0) SS0[row] = ssq_fix(sq);
    }
    { ssq_t* SSz = (ssq_t*)(ws + WS_SS) + MT; const size_t nz = (size_t)(NSS - 1) * MT;
      for (size_t i = (size_t)blockIdx.x * NTH + fresh_tid(wv); i < nz; i += (size_t)gridDim.x * NTH) SSz[i] = 0ull; }
    bf16_t* PB = (bf16_t*)(ws + WS_PB);
    const size_t n8 = (size_t)4 * MT * PLE / 8;
    for (size_t i = (size_t)blockIdx.x * NTH + fresh_tid(wv); i < n8; i += (size_t)gridDim.x * NTH) {
        const size_t e = i * 8; const int L = (int)(e / ((size_t)MT * PLE)); const size_t r = e % ((size_t)MT * PLE); const int row = (int)(r / PLE), c = (int)(r % PLE);
        const float* src = row < MP ? P.in[I_PP] + ((size_t)L * MP + row) * PLE + c : P.in[I_PS] + ((size_t)L * MS + (row - MP)) * PLE + c;
        *(u32x4*)(PB + e) = pack8(*(const f32x4*)src, *(const f32x4*)(src + 4));
    }
}

__device__ __forceinline__ void ld8(const bf16_t* p, float (&x)[8]) { const u32x4 w = *(const u32x4*)p; x[0] = bflo(w.x); x[1] = bfhi(w.x); x[2] = bflo(w.y); x[3] = bfhi(w.y); x[4] = bflo(w.z); x[5] = bfhi(w.z); x[6] = bflo(w.w); x[7] = bfhi(w.w); }
__device__ __forceinline__ void phase_ea(const Params& P, int wv, int j  ) {
    unsigned char* ws = P.ws; const bf16_t* BG = (const bf16_t*)(ws + AR_BG); const bf16_t* CV = (const bf16_t*)(ws + AR_CV); bf16_t* AA = (bf16_t*)(ws + AR_AA);
    const float* wc = P.in[I_WACONV] + (size_t)j * 3 * DM; const float* hist = P.in[I_STA] + (size_t)j * NBS * 2 * DM;
    const int gt = blockIdx.x * NTH + fresh_tid(wv), nthr = gridDim.x * NTH, c = (gt & 255) * 8, walker = gt >> 8, nwalk = nthr >> 8;
    const int per = (MT + nwalk - 1) / nwalk, r0 = walker * per, r1 = (r0 + per) < MT ? (r0 + per) : MT;
    float w0[8], w1[8], w2[8];
#pragma unroll
    for (int e = 0; e < 8; ++e) { w0[e] = wc[c + e]; w1[e] = wc[DM + c + e]; w2[e] = wc[2 * DM + c + e]; }
    float x1[8], x2[8];
#pragma unroll
    for (int e = 0; e < 8; ++e) { x1[e] = 0.f; x2[e] = 0.f; }
    if (r0 < r1) { int b, s, S; row_pos(r0, b, s, S); if (s >= 1) ld8(CV + (size_t)(r0 - 1) * DM + c, x1); if (s >= 2) ld8(CV + (size_t)(r0 - 2) * DM + c, x2); }
#pragma unroll 2
    for (int row = r0; row < r1; ++row) {
        int b, s, S; row_pos(row, b, s, S);
        float x0[8], g[8]; ld8(CV + (size_t)row * DM + c, x0); ld8(BG + (size_t)row * DM + c, g);
        if (s < 2) {
            if (row >= MP) { const float* h1 = hist + ((size_t)b * 2 + 1) * DM + c; const float* h0 = hist + ((size_t)b * 2) * DM + c;
#pragma unroll
                for (int e = 0; e < 8; ++e) { if (s == 0) { x1[e] = h1[e]; x2[e] = h0[e]; } else x2[e] = h1[e]; } }
            else {
#pragma unroll
                for (int e = 0; e < 8; ++e) { if (s == 0) { x1[e] = 0.f; x2[e] = 0.f; } else x2[e] = 0.f; } }
        }
        float o[8];
#pragma unroll
        for (int e = 0; e < 8; ++e) { o[e] = g[e] * (w0[e] * x2[e] + w1[e] * x1[e] + w2[e] * x0[e]); x2[e] = x1[e]; x1[e] = x0[e]; }
        u32x4 w; w.x = cvt_pk_bf16(o[0], o[1]); w.y = cvt_pk_bf16(o[2], o[3]); w.z = cvt_pk_bf16(o[4], o[5]); w.w = cvt_pk_bf16(o[6], o[7]);
        *(u32x4*)(AA + (size_t)row * DM + c) = w;
    }
}

__device__ __forceinline__ void phase_ef(const Params& P, int wv, int L) {
    unsigned char* ws = P.ws; const float* XB = (const float*)(ws + AR_XB); bf16_t* ACT = (bf16_t*)(ws + AR_ACT);
    const float* wc = P.in[I_WFCONV] + (size_t)L * 3 * DFF2; const float* bc = P.in[I_BFCONV] + (size_t)L * DFF2; const float* hist = P.in[I_STF] + (size_t)L * NBS * 2 * DFF2;
    const int per_row = DFF / 4, total = (MT / 64) * 2 * per_row;
    for (int i = blockIdx.x * NTH + fresh_tid(wv); i < total; i += gridDim.x * NTH) {
        const int blk = i / (2 * per_row), r = (i / per_row) & 1, c = (i % per_row) * 4, row = blk * 64 + r; int b, s, S; row_pos(row, b, s, S);
        f32x4 o;
        float ug[4], uu[4];
#pragma unroll
        for (int h = 0; h < 2; ++h) {
            const int cc = c + h * DFF; f32x4 x[3];
            x[2] = *(const f32x4*)(XB + ((size_t)blk * 4 + 2 + r) * DFF2 + cc);
#pragma unroll
            for (int d = 1; d <= 2; ++d) {
                const int p = r - d;
                if (p >= 0) x[2 - d] = *(const f32x4*)(XB + ((size_t)blk * 4 + 2 + p) * DFF2 + cc);
                else if (s - d >= 0) x[2 - d] = *(const f32x4*)(XB + ((size_t)(blk - 1) * 4 + (2 + p)) * DFF2 + cc);
                else if (row >= MP) x[2 - d] = *(const f32x4*)(hist + ((size_t)b * 2 + (2 + (s - d))) * DFF2 + cc);
                else x[2 - d] = (f32x4){0.f, 0.f, 0.f, 0.f};
            }
            const f32x4 w0 = *(const f32x4*)(wc + cc), w1 = *(const f32x4*)(wc + DFF2 + cc), w2 = *(const f32x4*)(wc + 2 * DFF2 + cc), bb = *(const f32x4*)(bc + cc);
            const f32x4 y = w0 * x[0] + w1 * x[1] + w2 * x[2] + bb;
#pragma unroll
            for (int e = 0; e < 4; ++e) { if (h == 0) ug[e] = y[e]; else uu[e] = y[e]; }
        }
#pragma unroll
        for (int e = 0; e < 4; ++e) o[e] = siluf_(ug[e]) * uu[e];
        u32x2 w; w.x = cvt_pk_bf16(o[0], o[1]); w.y = cvt_pk_bf16(o[2], o[3]);
        *(u32x2*)(ACT + (size_t)row * DFF + c) = w;
    }
}


__device__ __forceinline__ void phase_reduce(const Params& P, int wv, int K, const float* PART, ssq_t* ssn, const ssq_t* ssc  , const bf16_t* HBI, bf16_t* HB) {
    unsigned char* ws = P.ws; float* H = (float*)(ws + WS_H); const bf16_t* PPB = (const bf16_t*)(ws + AR_PPB);
    pg8::StaticOrder S; S.init(MT, DM, K, (int)gridDim.x, 0, true);
    if (S.nreg == S.nwg) return;
    const int nleft = S.nwg - S.nreg;
    const int tid_ = fresh_tid(wv), lane = tid_ & 63, gw = blockIdx.x * 8 + (tid_ >> 6), nw = gridDim.x * 8;
    for (int tr = gw; tr < nleft * 256; tr += nw) {
        const int j = tr >> 8, r = tr & 255, pq = S.map(S.nreg + j);
        const int row = (pq >> 16) * 256 + r, col = (pq & 0xffff) * 256 + 4 * lane;
        f32x4 s = (f32x4){0.f, 0.f, 0.f, 0.f};
#pragma unroll
        for (int k = 0; k < 8; ++k) s += *(const f32x4*)(PART + (size_t)(j * 8 + k) * 65536 + (size_t)r * 256 + 4 * lane);
        const size_t off = (size_t)row * DM + col; f32x4 h;
        if (RES16) { const u32x2 hw = *(const u32x2*)(HBI + off); h = (f32x4){bflo(hw.x), bfhi(hw.x), bflo(hw.y), bfhi(hw.y)}; } else h = *(const f32x4*)(H + off);
        if (ssc) { const float rs = rstd_of(ssc, row); const u32x2 pw = *(const u32x2*)(PPB + off);
            h[0] += bflo(pw.x) * sigmoidf_(s[0] * rs); h[1] += bfhi(pw.x) * sigmoidf_(s[1] * rs); h[2] += bflo(pw.y) * sigmoidf_(s[2] * rs); h[3] += bfhi(pw.y) * sigmoidf_(s[3] * rs); }
        else h += s;
        if (!RES16) *(f32x4*)(H + off) = h;
        u32x2 w; w.x = cvt_pk_bf16(h[0], h[1]); w.y = cvt_pk_bf16(h[2], h[3]); *(u32x2*)(HB + off) = w;
        float sq = (h[0] * h[0] + h[1] * h[1]) + (h[2] * h[2] + h[3] * h[3]); sq = wave_sum(sq);
        if (lane == 0) atomicAdd(ssn + row, ssq_fix(sq));
    }
}

__device__ __forceinline__ void phase_final(const Params& P, int wv, const bf16_t* HB) {
    unsigned char* ws = P.ws; const float* H = (const float*)(ws + WS_H); const ssq_t* ss = (const ssq_t*)(ws + WS_SS) + (size_t)12 * MT; const float* g = P.in[I_GFIN];
    const int tid_ = fresh_tid(wv), lane = tid_ & 63, gw = blockIdx.x * 8 + (tid_ >> 6), nw = gridDim.x * 8;
    for (int row = gw; row < MT; row += nw) {
        const float rs = rstd_of(ss, row);
        float* dst = row < MP ? P.out + O_YP + (size_t)row * DM : P.out + O_YS + (size_t)(row - MP) * DM;
#pragma unroll
        for (int j = 0; j < 8; ++j) { const int c = (j * 64 + lane) * 4; f32x4 a;
            if (RES16) { const u32x2 hw = *(const u32x2*)(HB + (size_t)row * DM + c); a = (f32x4){bflo(hw.x), bfhi(hw.x), bflo(hw.y), bfhi(hw.y)}; } else a = *(const f32x4*)(H + (size_t)row * DM + c);
            const f32x4 gg = *(const f32x4*)(g + c); *(f32x4*)(dst + c) = a * rs * gg; }
    }
}

__device__ __forceinline__ void phase_ba(const Params& P, int wv, const ssq_t* ss, const bf16_t* HB) {
    unsigned char* ws = P.ws; const bf16_t* WBA = (const bf16_t*)(ws + WS_WBBA); float* BA = (float*)(ws + WS_BA);
    const int tid_ = fresh_tid(wv), lane = tid_ & 63, fr = lane & 15, fq = lane >> 4, gw = blockIdx.x * 8 + (tid_ >> 6), nw = gridDim.x * 8;
    for (int rt = gw; rt < MT / 16; rt += nw) {
        f32x4 acc[4];
#pragma unroll
        for (int n = 0; n < 4; ++n) acc[n] = (f32x4){0.f, 0.f, 0.f, 0.f};
        const bf16_t* ap = HB + (size_t)(rt * 16 + fr) * DM + 8 * fq;
        for (int k0 = 0; k0 < DM; k0 += 32) {
            const bf16x8 a = *(const bf16x8*)(ap + k0);
#pragma unroll
            for (int n = 0; n < 4; ++n) { const bf16x8 b = *(const bf16x8*)(WBA + (size_t)(n * 16 + fr) * DM + k0 + 8 * fq); acc[n] = __builtin_amdgcn_mfma_f32_16x16x32_bf16(b, a, acc[n], 0, 0, 0); }
        }
        const int row = rt * 16 + fr; const float rs = rstd_of(ss, row);
#pragma unroll
        for (int n = 0; n < 4; ++n) { f32x4 v = acc[n] * rs;
#pragma unroll
            for (int r = 0; r < 4; ++r) { if (n < 2) v[r] = sigmoidf_(v[r]); else { const int hv = (n - 2) * 16 + 4 * fq + r; const float aa = v[r] + P.in[I_DTB][hv]; v[r] = -__expf(P.in[I_ALOG][hv]) * (aa > 20.f ? aa : log1pf(__expf(aa))); } }
            *(f32x4*)(BA + (size_t)row * 64 + n * 16 + 4 * fq) = v; }
    }
}
__device__ __forceinline__ void phase_ec(const Params& P, int wv, LAS unsigned char* lds) {
    unsigned char* ws = P.ws; bf16_t* QKV = (bf16_t*)(ws + AR_QKV); bf16_t* VTP = (bf16_t*)(ws + AR_VTP); bf16_t* VTS = (bf16_t*)(ws + AR_VTS); bf16_t* KS = (bf16_t*)(ws + AR_KS);
    const float* gq = P.in[I_GCQ]; const float* gk = P.in[I_GCK];
    LAS bf16_t* tv = (LAS bf16_t*)lds;
    const int tid = fresh_tid(wv), lane = tid & 63, wid = tid >> 6;
    const int n_main = (MT / 64) * 16, n_hist = NBS * 16 * 8;
    for (int item = blockIdx.x; item < n_main + n_hist; item += gridDim.x) {
        bf16_t* vt_dst; int vt_ld;
        if (item < n_main) {
            const int chunk = item >> 4, h = item & 15, row0 = chunk * 64;
            const float gq0 = gq[2 * lane], gq1 = gq[2 * lane + 1], gk0 = gk[2 * lane], gk1 = gk[2 * lane + 1];
#pragma unroll 4
            for (int t = wid * 8; t < wid * 8 + 8; ++t) {
                const int row = row0 + t; int b, s, S; row_pos(row, b, s, S);
                unsigned* qp = (unsigned*)(QKV + (size_t)row * 6144 + h * 128) + lane; unsigned* kp = qp + 1024; const unsigned* vp = qp + 2048;
                const unsigned qw = *qp, kw = *kp, vw = *vp;
                float q0 = bflo(qw), q1 = bfhi(qw), k0 = bflo(kw), k1 = bfhi(kw);
                const float qs = wave_sum(q0 * q0 + q1 * q1), ks = wave_sum(k0 * k0 + k1 * k1);
                const float rq = rsqrtf(qs * (1.0f / 128.0f) + EPS) * 0.08838834764831845f, rk = rsqrtf(ks * (1.0f / 128.0f) + EPS);
                q0 *= rq * gq0; q1 *= rq * gq1; k0 *= rk * gk0; k1 *= rk * gk1;
                *qp = cvt_pk_bf16(q0, q1); const unsigned kn = cvt_pk_bf16(k0, k1); *kp = kn;
                *(LAS unsigned*)(tv + t * 130 + 2 * lane) = vw;
                if (row < MP) { if (s >= SEQ - 512) { const size_t o = (((size_t)b * 512 + (s - (SEQ - 512))) * 16 + h) * 128 + 2 * lane;
                        *(f32x2*)(P.out + O_PCK + o) = (f32x2){k0, k1}; *(f32x2*)(P.out + O_PCV + o) = (f32x2){bflo(vw), bfhi(vw)}; } }
                else { const size_t o = (((size_t)b * 64 + s) * 16 + h) * 128 + 2 * lane;
                    *(f32x2*)(P.out + O_SCK + o) = (f32x2){k0, k1}; *(f32x2*)(P.out + O_SCV + o) = (f32x2){bflo(vw), bfhi(vw)};
                    *(unsigned*)(KS + (((size_t)b * 576 + 512 + s) * 16 + h) * 128 + 2 * lane) = kn; }
            }
            if (row0 < MP) { const int b = row0 >> 12, s0 = row0 & 4095; vt_dst = VTP + ((size_t)(b * 16 + h) * 128) * 4096 + s0; vt_ld = 4096; }
            else { const int b = (row0 - MP) >> 6; vt_dst = VTS + ((size_t)(b * 16 + h) * 128) * 576 + 512; vt_ld = 576; }
        } else {
            const int it = item - n_main, b = it >> 7, h = (it >> 3) & 15, jc = it & 7;
            const float* ck = P.in[I_CK]; const float* cv = P.in[I_CV];
            for (int t = wid * 8; t < wid * 8 + 8; ++t) {
                const size_t o = (((size_t)b * 512 + jc * 64 + t) * 16 + h) * 128 + 2 * lane;
                const f32x2 kk = *(const f32x2*)(ck + o), vv = *(const f32x2*)(cv + o);
                *(unsigned*)(KS + (((size_t)b * 576 + jc * 64 + t) * 16 + h) * 128 + 2 * lane) = cvt_pk_bf16(kk.x, kk.y);
                *(LAS unsigned*)(tv + t * 130 + 2 * lane) = cvt_pk_bf16(vv.x, vv.y);
            }
            vt_dst = VTS + ((size_t)(b * 16 + h) * 128) * 576 + jc * 64; vt_ld = 576;
        }
        __syncthreads();
        { const int d = tid >> 2, tg = tid & 3; unsigned w[8];
#pragma unroll
          for (int e = 0; e < 8; ++e) w[e] = (unsigned)tv[(16 * tg + 2 * e) * 130 + d] | ((unsigned)tv[(16 * tg + 2 * e + 1) * 130 + d] << 16);
          bf16_t* dp = vt_dst + (size_t)d * vt_ld + 16 * tg;
          *(u32x4*)dp = (u32x4){w[0], w[1], w[2], w[3]}; *(u32x4*)(dp + 8) = (u32x4){w[4], w[5], w[6], w[7]}; }
        __syncthreads();
    }
}

__device__ __forceinline__ void phase_att_sample(const Params& P, int wv) {
    unsigned char* ws = P.ws; const bf16_t* QKV = (const bf16_t*)(ws + AR_QKV); const bf16_t* VTP = (const bf16_t*)(ws + AR_VTP); const bf16_t* VTS = (const bf16_t*)(ws + AR_VTS);
    const bf16_t* KS = (const bf16_t*)(ws + AR_KS); bf16_t* OATT = (bf16_t*)(ws + AR_OATT); const float* relb = P.in[I_RELB];
    const int tid_ = fresh_tid(wv), lane = tid_ & 63, fr = lane & 15, fq = lane >> 4, gw = (tid_ >> 6) * gridDim.x + blockIdx.x, nw = gridDim.x * 8;
    const int n_items = (MT / 64) * 16;
    for (int wi = 4096 * 2 + gw; wi < n_items * 2; wi += nw) {
        const int item = wi >> 1, qs = wi & 1;
        int c, h, row0, kstride, vstride; const bf16_t* Kb; const bf16_t* Vb;
        if (item < 4096) { const int b = item >> 10; c = (item >> 4) & 63; h = item & 15; row0 = b * 4096 + c * 64 + qs * 32;
            Kb = QKV + (size_t)(b * 4096) * 6144 + 2048 + h * 128; kstride = 6144; Vb = VTP + ((size_t)(b * 16 + h) * 128) * 4096; vstride = 4096; }
        else { const int it = item - 4096, b = it >> 4; h = it & 15; c = 8; row0 = MP + b * 64 + qs * 32;
            Kb = KS + (size_t)(b * 576) * 2048 + h * 128; kstride = 2048; Vb = VTS + ((size_t)(b * 16 + h) * 128) * 576; vstride = 576; }
        const float* bias = relb + h * 257;
        bf16x8 qf[2][4];
#pragma unroll
        for (int qt = 0; qt < 2; ++qt) { const bf16_t* qp = QKV + (size_t)(row0 + 16 * qt + fr) * 6144 + h * 128 + 8 * fq;
#pragma unroll
            for (int ks = 0; ks < 4; ++ks) qf[qt][ks] = *(const bf16x8*)(qp + 32 * ks); }
        const int qpos0 = c * 64 + qs * 32 + fr;
        float bmx = fmaxf(fmaxf(bias[lane], bias[lane + 64]), fmaxf(bias[lane + 128], bias[lane + 192])); bmx = fmaxf(bmx, bias[256]);
        bmx = fmaxf(bmx, __shfl_xor(bmx, 1)); bmx = fmaxf(bmx, __shfl_xor(bmx, 2)); bmx = fmaxf(bmx, __shfl_xor(bmx, 4)); bmx = fmaxf(bmx, __shfl_xor(bmx, 8)); bmx = fmaxf(bmx, __shfl_xor(bmx, 16)); bmx = fmaxf(bmx, __shfl_xor(bmx, 32));
        float mfix[2];
#pragma unroll
        for (int qt = 0; qt < 2; ++qt) { float q2 = 0.f;
#pragma unroll
            for (int ks = 0; ks < 4; ++ks)
#pragma unroll
                for (int e = 0; e < 8; ++e) { const float v = bf2f((bf16_t)qf[qt][ks][e]); q2 += v * v; }
            q2 += __shfl_xor(q2, 16); q2 += __shfl_xor(q2, 32);
            mfix[qt] = 16.0f * sqrtf(q2) + bmx; }
        float l_run[2] = {0.f, 0.f};
        f32x4 o[2][8];
#pragma unroll
        for (int qt = 0; qt < 2; ++qt)
#pragma unroll
            for (int dt = 0; dt < 8; ++dt) o[qt][dt] = (f32x4){0.f, 0.f, 0.f, 0.f};
        const int kc0 = c > 8 ? c - 8 : 0, kb_end = (c + 1) * 2;
        bf16x8 kf[2][4];
#define ATT_LOADK(KF, kb_) do { const int k0_ = (kb_) * 32; \
            _Pragma("unroll") for (int t = 0; t < 2; ++t) { const bf16_t* kp = Kb + (size_t)(k0_ + 8 * (fr >> 2) + 4 * t + (fr & 3)) * kstride + 8 * fq; \
                _Pragma("unroll") for (int ks = 0; ks < 4; ++ks) KF[t][ks] = *(const bf16x8*)(kp + 32 * ks); } } while (0)
        ATT_LOADK(kf, kc0 * 2);
        for (int kb = kc0 * 2; kb < kb_end; ++kb) {
            const int k0 = kb * 32;
            bf16x8 vf[8];
            { const bf16_t* vp = Vb + (size_t)fr * vstride + k0 + 8 * fq;
#pragma unroll
              for (int dt = 0; dt < 8; ++dt) vf[dt] = *(const bf16x8*)(vp + (size_t)(16 * dt) * vstride); }
            f32x4 s[2][2];
#pragma unroll
            for (int qt = 0; qt < 2; ++qt)
#pragma unroll
                for (int t = 0; t < 2; ++t) { s[qt][t] = (f32x4){0.f, 0.f, 0.f, 0.f};
#pragma unroll
                    for (int ks = 0; ks < 4; ++ks) s[qt][t] = __builtin_amdgcn_mfma_f32_16x16x32_bf16(kf[t][ks], qf[qt][ks], s[qt][t], 0, 0, 0); }
            ATT_LOADK(kf, kb + 1 < kb_end ? kb + 1 : kb);
            const bool far = qpos0 - (k0 + 31) >= 128;
#pragma unroll
            for (int qt = 0; qt < 2; ++qt) {
                const int qpos = qpos0 + 16 * qt; const float mf = mfix[qt];
                float ps = 0.f;
                if (far) { const float bfar = bias[256] - mf;
#pragma unroll
                    for (int t = 0; t < 2; ++t)
#pragma unroll
                        for (int r = 0; r < 4; ++r) { s[qt][t][r] = __expf(s[qt][t][r] + bfar); ps += s[qt][t][r]; }
                } else {
#pragma unroll
                    for (int t = 0; t < 2; ++t)
#pragma unroll
                        for (int r = 0; r < 4; ++r) { int rel = qpos - (k0 + 8 * fq + 4 * t + r); rel = rel > 128 ? 128 : (rel < -128 ? -128 : rel); s[qt][t][r] = __expf(s[qt][t][r] + bias[rel + 128] - mf); ps += s[qt][t][r]; }
                }
                l_run[qt] += ps;
                u32x4 pw; pw.x = cvt_pk_bf16(s[qt][0][0], s[qt][0][1]); pw.y = cvt_pk_bf16(s[qt][0][2], s[qt][0][3]); pw.z = cvt_pk_bf16(s[qt][1][0], s[qt][1][1]); pw.w = cvt_pk_bf16(s[qt][1][2], s[qt][1][3]);
                bf16x8 pf; __builtin_memcpy(&pf, &pw, 16);
#pragma unroll
                for (int dt = 0; dt < 8; ++dt) o[qt][dt] = __builtin_amdgcn_mfma_f32_16x16x32_bf16(vf[dt], pf, o[qt][dt], 0, 0, 0);
            }
        }
#undef ATT_LOADK
#pragma unroll
        for (int qt = 0; qt < 2; ++qt) {
            float lt = l_run[qt]; lt += __shfl_xor(lt, 16); lt += __shfl_xor(lt, 32);
            const float inv = 1.0f / lt;
            bf16_t* op = OATT + (size_t)(row0 + 16 * qt + fr) * DM + h * 128 + 4 * fq;
#pragma unroll
            for (int dt = 0; dt < 8; ++dt) { const f32x4 v = o[qt][dt] * inv; u32x2 w; w.x = cvt_pk_bf16(v[0], v[1]); w.y = cvt_pk_bf16(v[2], v[3]); *(u32x2*)(op + 16 * dt) = w; }
        }
    }
}

__device__ __forceinline__ void phase_att(const Params& P, int wv, LAS unsigned char* lds) {
    unsigned char* ws = P.ws; const bf16_t* QKV = (const bf16_t*)(ws + AR_QKV); const bf16_t* VTP = (const bf16_t*)(ws + AR_VTP); bf16_t* OATT = (bf16_t*)(ws + AR_OATT); const float* relb = P.in[I_RELB];
    const int tid_ = fresh_tid(wv), lane = tid_ & 63, fr = lane & 15, fq = lane >> 4, wid = __builtin_amdgcn_readfirstlane(tid_ >> 6);
    for (int wgi = blockIdx.x; wgi < 4 * 16 * 16; wgi += gridDim.x) {
        const int b = wgi >> 8, h = (wgi >> 4) & 15, cq = wgi & 15, c = 4 * cq + (wid >> 1), qs = wid & 1, row0 = b * 4096 + c * 64 + qs * 32;
        const bf16_t* Kb = QKV + (size_t)(b * 4096) * 6144 + 2048 + h * 128; const bf16_t* Vb = VTP + ((size_t)(b * 16 + h) * 128) * 4096; const int kstride = 6144, vstride = 4096;
        const float* bias = relb + h * 257;
        bf16x8 qf[2][4];
#pragma unroll
        for (int qt = 0; qt < 2; ++qt) { const bf16_t* qp = QKV + (size_t)(row0 + 16 * qt + fr) * 6144 + h * 128 + 8 * fq;
#pragma unroll
            for (int ks = 0; ks < 4; ++ks) qf[qt][ks] = *(const bf16x8*)(qp + 32 * ks); }
        const int qpos0 = c * 64 + qs * 32 + fr;
        float bmx = fmaxf(fmaxf(bias[lane], bias[lane + 64]), fmaxf(bias[lane + 128], bias[lane + 192])); bmx = fmaxf(bmx, bias[256]);
        bmx = fmaxf(bmx, __shfl_xor(bmx, 1)); bmx = fmaxf(bmx, __shfl_xor(bmx, 2)); bmx = fmaxf(bmx, __shfl_xor(bmx, 4)); bmx = fmaxf(bmx, __shfl_xor(bmx, 8)); bmx = fmaxf(bmx, __shfl_xor(bmx, 16)); bmx = fmaxf(bmx, __shfl_xor(bmx, 32));
        float mfix[2];
#pragma unroll
        for (int qt = 0; qt < 2; ++qt) { float q2 = 0.f;
#pragma unroll
            for (int ks = 0; ks < 4; ++ks)
#pragma unroll
                for (int e = 0; e < 8; ++e) { const float v = bf2f((bf16_t)qf[qt][ks][e]); q2 += v * v; }
            q2 += __shfl_xor(q2, 16); q2 += __shfl_xor(q2, 32);
            mfix[qt] = 16.0f * sqrtf(q2) + bmx; }
        float l_run[2] = {0.f, 0.f};
        f32x4 o[2][8];
#pragma unroll
        for (int qt = 0; qt < 2; ++qt)
#pragma unroll
            for (int dt = 0; dt < 8; ++dt) o[qt][dt] = (f32x4){0.f, 0.f, 0.f, 0.f};
        const int kt0 = cq >= 2 ? 4 * cq - 8 : 0, kt1 = 4 * cq + 3;
        bf16x8 pre[4];
#define ATT_FETCH(kt_) do { const int k0_ = (kt_) * 64 + 32 * ((wid & 3) >> 1); \
            if (wid < 4) { const bf16_t* kp = Kb + (size_t)(k0_ + 8 * (fr >> 2) + 4 * (wid & 1) + (fr & 3)) * kstride + 8 * fq; \
                _Pragma("unroll") for (int j = 0; j < 4; ++j) pre[j] = *(const bf16x8*)(kp + 32 * j); } \
            else { const bf16_t* vp = Vb + (size_t)(64 * (wid & 1) + fr) * vstride + k0_ + 8 * fq; \
                _Pragma("unroll") for (int j = 0; j < 4; ++j) pre[j] = *(const bf16x8*)(vp + (size_t)(16 * j) * vstride); } } while (0)
#define ATT_PARK(buf_) do { _Pragma("unroll") for (int j = 0; j < 4; ++j) *(LAS bf16x8*)(lds + (buf_) * 32768 + (4 * wid + j) * 1024 + lane * 16) = pre[j]; } while (0)
        __syncthreads();
        ATT_FETCH(kt0); ATT_PARK(0);
        __syncthreads();
        for (int kt = kt0; kt <= kt1; ++kt) {
            const int buf = (kt - kt0) & 1;
            if (kt < kt1) ATT_FETCH(kt + 1);
            if (kt >= c - 8 && kt <= c) {
#pragma unroll
                for (int blk = 0; blk < 2; ++blk) {
                    const int k0 = kt * 64 + 32 * blk;
                    const LAS unsigned char* fb = lds + buf * 32768 + lane * 16;
                    bf16x8 kf[2][4], vf[8];
#pragma unroll
                    for (int t = 0; t < 2; ++t)
#pragma unroll
                        for (int ks = 0; ks < 4; ++ks) kf[t][ks] = *(const LAS bf16x8*)(fb + (blk * 8 + t * 4 + ks) * 1024);
#pragma unroll
                    for (int dt = 0; dt < 8; ++dt) vf[dt] = *(const LAS bf16x8*)(fb + (16 + blk * 8 + dt) * 1024);
                    f32x4 s[2][2];
#pragma unroll
                    for (int qt = 0; qt < 2; ++qt)
#pragma unroll
                        for (int t = 0; t < 2; ++t) { s[qt][t] = (f32x4){0.f, 0.f, 0.f, 0.f};
#pragma unroll
                            for (int ks = 0; ks < 4; ++ks) s[qt][t] = __builtin_amdgcn_mfma_f32_16x16x32_bf16(kf[t][ks], qf[qt][ks], s[qt][t], 0, 0, 0); }
                    const bool far = qpos0 - (k0 + 31) >= 128;
#pragma unroll
                    for (int qt = 0; qt < 2; ++qt) {
                        const int qpos = qpos0 + 16 * qt; const float mf = mfix[qt];
                        float ps = 0.f;
                        if (far) { const float bfar = bias[256] - mf;
#pragma unroll
                            for (int t = 0; t < 2; ++t)
#pragma unroll
                                for (int r = 0; r < 4; ++r) { s[qt][t][r] = __expf(s[qt][t][r] + bfar); ps += s[qt][t][r]; }
                        } else {
#pragma unroll
                            for (int t = 0; t < 2; ++t)
#pragma unroll
                                for (int r = 0; r < 4; ++r) { int rel = qpos - (k0 + 8 * fq + 4 * t + r); rel = rel > 128 ? 128 : (rel < -128 ? -128 : rel); s[qt][t][r] = __expf(s[qt][t][r] + bias[rel + 128] - mf); ps += s[qt][t][r]; }
                        }
                        l_run[qt] += ps;
                        u32x4 pw; pw.x = cvt_pk_bf16(s[qt][0][0], s[qt][0][1]); pw.y = cvt_pk_bf16(s[qt][0][2], s[qt][0][3]); pw.z = cvt_pk_bf16(s[qt][1][0], s[qt][1][1]); pw.w = cvt_pk_bf16(s[qt][1][2], s[qt][1][3]);
                        bf16x8 pf; __builtin_memcpy(&pf, &pw, 16);
#pragma unroll
                        for (int dt = 0; dt < 8; ++dt) o[qt][dt] = __builtin_amdgcn_mfma_f32_16x16x32_bf16(vf[dt], pf, o[qt][dt], 0, 0, 0);
                    }
                }
            }
            if (kt < kt1) ATT_PARK(buf ^ 1);
            __syncthreads();
        }
#undef ATT_FETCH
#undef ATT_PARK
#pragma unroll
        for (int qt = 0; qt < 2; ++qt) {
            float lt = l_run[qt]; lt += __shfl_xor(lt, 16); lt += __shfl_xor(lt, 32);
            const float inv = 1.0f / lt;
            bf16_t* op = OATT + (size_t)(row0 + 16 * qt + fr) * DM + h * 128 + 4 * fq;
#pragma unroll
            for (int dt = 0; dt < 8; ++dt) { const f32x4 v = o[qt][dt] * inv; u32x2 w; w.x = cvt_pk_bf16(v[0], v[1]); w.y = cvt_pk_bf16(v[2], v[3]); *(u32x2*)(op + 16 * dt) = w; }
        }
    }
}
__device__ __forceinline__ void phase_qkn(const Params& P, int wv) {
    unsigned char* ws = P.ws; bf16_t* QKVP = (bf16_t*)(ws + AR_QKVP); const bf16_t* HALO = (const bf16_t*)(ws + AR_HALO); const float* wconv = P.in[I_WBCONV]; const float* histB = P.in[I_STBC];
    const int tid_ = fresh_tid(wv), lane = tid_ & 63, gw = blockIdx.x * 8 + (tid_ >> 6), nw = gridDim.x * 8;
    for (int wi = gw; wi < (MT / 64) * 32; wi += nw) {
        const int ch = wi >> 5, sl = wi & 31, col = sl * 128 + 2 * lane, r0 = ch * 64; int b, s0, S; row_pos(r0, b, s0, S);
        float w0[4], w1[4];
#pragma unroll
        for (int j = 0; j < 4; ++j) { w0[j] = wconv[j * DNC + col]; w1[j] = wconv[j * DNC + col + 1]; }
        float a0[3], a1[3];
#pragma unroll
        for (int j = 0; j < 3; ++j) {
            if (s0 > 0) { const unsigned hw = *(const unsigned*)(HALO + ((size_t)(ch - 1) * 3 + j) * 4096 + col); a0[j] = bflo(hw); a1[j] = bfhi(hw); }
            else if (r0 >= MP) { const float* hp = histB + ((size_t)b * 3 + j) * DNC + col; a0[j] = hp[0]; a1[j] = hp[1]; }
            else { a0[j] = 0.f; a1[j] = 0.f; }
        }
        const float qsc = sl < 16 ? 0.08838834764831845f : 1.0f;
        unsigned* rp = (unsigned*)(QKVP + (size_t)r0 * DNC + col);
        for (int t8 = 0; t8 < 64; t8 += 8) {
            unsigned raw[8];
#pragma unroll
            for (int i = 0; i < 8; ++i) raw[i] = rp[(size_t)(t8 + i) * (DNC / 2)];
#pragma unroll
            for (int i = 0; i < 8; ++i) {
                const float x0 = bflo(raw[i]), x1 = bfhi(raw[i]);
                float y0 = w0[0] * a0[0] + w0[1] * a0[1] + w0[2] * a0[2] + w0[3] * x0, y1 = w1[0] * a1[0] + w1[1] * a1[1] + w1[2] * a1[2] + w1[3] * x1;
                y0 = siluf_(y0); y1 = siluf_(y1);
                const float sc = rsqrtf(wave_sum(y0 * y0 + y1 * y1) + EPS) * qsc;
                rp[(size_t)(t8 + i) * (DNC / 2)] = cvt_pk_bf16(y0 * sc, y1 * sc);
                a0[0] = a0[1]; a0[1] = a0[2]; a0[2] = x0; a1[0] = a1[1]; a1[1] = a1[2]; a1[2] = x1;
            }
        }
    }
}

#include <type_traits>
typedef short bf16x4 __attribute__((ext_vector_type(4)));
template <int K> __device__ __forceinline__ f32x4 tile_mma(const LAS bf16_t* A, int lda, const LAS bf16_t* Bt, int ldb, int m0, int n0, f32x4 acc, int fr, int fq) {
#pragma unroll
    for (int k0 = 0; k0 < K; k0 += 32) {
        const bf16x8 a = *(const LAS bf16x8*)(A + (m0 + fr) * lda + k0 + 8 * fq);
        const bf16x8 b = *(const LAS bf16x8*)(Bt + (n0 + fr) * ldb + k0 + 8 * fq);
        acc = __builtin_amdgcn_mfma_f32_16x16x32_bf16(b, a, acc, 0, 0, 0);
    }
    return acc;
}
__device__ __forceinline__ f32x4 tile_mma16(const LAS bf16_t* A, int lda, const LAS bf16_t* Bt, int ldb, f32x4 acc, int fr, int fq) {
    const bf16x4 a = *(const LAS bf16x4*)(A + fr * lda + 4 * fq);
    const bf16x4 b = *(const LAS bf16x4*)(Bt + fr * ldb + 4 * fq);
    return __builtin_amdgcn_mfma_f32_16x16x16bf16_1k(b, a, acc, 0, 0, 0);
}
constexpr int DR_LD = 0, DR_MISC = 4352, DR_CW = 5376, DR_LB = 10496, DR_TB = 19712, DR_KN = 28928, DR_TT = DR_KN, DR_PT = DR_KN + 9216, DR_QN = 46336, DR_KDT = 63744, DR_RT = 82176, DR_VNT = 91392,
              DR_VBT = 100608, DR_AI = 109824, DR_ST = 119040, DR_END = 136448;

#ifdef DBG_DR_DUMP
#define DR_DUMP(slot) do { if (item == 8 && n == 0) { __syncthreads(); for (int i_ = tid0; i_ < DR_END / 4; i_ += NTH) ((unsigned*)(ws + WS_END))[(size_t)(slot) * (DR_END / 4) + i_] = ((const LAS unsigned*)lds)[i_]; __syncthreads(); } } while (0)
#else
#define DR_DUMP(slot) do { } while (0)
#endif
template <int SKIP = 0>
__device__ __forceinline__ void phase_dr(const Params& P, int wv, LAS unsigned char* lds) {
    unsigned char* ws = P.ws; const bf16_t* QKVP = (const bf16_t*)(ws + AR_QKVP); bf16_t* ODR = (bf16_t*)(ws + AR_ODR); const float* BA = (const float*)(ws + WS_BA);
    const float* wconv = P.in[I_WBCONV]; const float* histB = P.in[I_STBC];
    LAS float* LD = (LAS float*)(lds + DR_LD); LAS bf16_t* LB = (LAS bf16_t*)(lds + DR_LB); LAS bf16_t* TB = (LAS bf16_t*)(lds + DR_TB); LAS bf16_t* TT = (LAS bf16_t*)(lds + DR_TT); LAS bf16_t* PT = (LAS bf16_t*)(lds + DR_PT);
    LAS bf16_t* KN = (LAS bf16_t*)(lds + DR_KN); LAS bf16_t* QN = (LAS bf16_t*)(lds + DR_QN); LAS bf16_t* KDT = (LAS bf16_t*)(lds + DR_KDT); LAS bf16_t* RT = (LAS bf16_t*)(lds + DR_RT); LAS bf16_t* VNT = (LAS bf16_t*)(lds + DR_VNT);
    LAS bf16_t* VBT = (LAS bf16_t*)(lds + DR_VBT); LAS bf16_t* AI = (LAS bf16_t*)(lds + DR_AI); LAS bf16_t* ST = (LAS bf16_t*)(lds + DR_ST);
    LAS float* GC = (LAS float*)(lds + DR_MISC); LAS float* BETA = GC + 64; LAS float* EG = GC + 128; LAS float* BEG = GC + 192; LAS float* CW = (LAS float*)(lds + DR_CW);
    const int tid0 = fresh_tid(wv), lane0 = tid0 & 63, wid0 = __builtin_amdgcn_readfirstlane(tid0 >> 6);
    const __amdgpu_buffer_rsrc_t rsrc_ = __builtin_amdgcn_make_buffer_rsrc((void*)QKVP, 0, (int)((size_t)MT * DNC * 2), 0x00020000);
    for (int item = blockIdx.x; item < 256 + 1024; item += gridDim.x) {
        int b, hv, half, rowbase, nchunks; bool samp;
        if (item < 256) { samp = false; b = item >> 6; hv = (item >> 1) & 31; half = item & 1; rowbase = b * SEQ; nchunks = SEQ / 64; }
        else { const int it = item - 256; samp = true; b = it >> 6; hv = (it >> 1) & 31; half = it & 1; rowbase = MP + b * DSEQ; nchunks = 1; }
        const int hk = hv >> 1;
        { const int lane = launder_v(lane0), wid = launder_s(wid0);
          const int cq = hk * 128 + 2 * lane, ck = 2048 + hk * 128 + 2 * lane, cvv = 4096 + hv * 128 + half * 64 + lane;
          if (wid == 0) {
#pragma unroll
            for (int j = 0; j < 4; ++j) { CW[(j * 5 + 0) * 64 + lane] = wconv[j * DNC + cq]; CW[(j * 5 + 1) * 64 + lane] = wconv[j * DNC + cq + 1]; CW[(j * 5 + 2) * 64 + lane] = wconv[j * DNC + ck];
                CW[(j * 5 + 3) * 64 + lane] = wconv[j * DNC + ck + 1]; CW[(j * 5 + 4) * 64 + lane] = wconv[j * DNC + cvv]; }
          }
          for (int i = wid * 64 + lane; i < 64 * 36; i += NTH) ((LAS unsigned*)TB)[i] = 0u;
        }
        auto run_item = [&](auto role_tag) {
        constexpr int ROLE = decltype(role_tag)::value;
        const int lane_i = launder_v(lane0), wid_i = launder_s(wid0), smt = wid_i - 4;
        f32x4 sacc[8];
        float* ssm_out = (samp ? P.out + O_SBS : P.out + O_PBS) + ((size_t)(b * 32 + hv) * 128) * 128;
        { const int fr = lane_i & 15, fq = lane_i >> 4;
#pragma unroll
          for (int j = 0; j < 8; ++j) {
            if (ROLE == 1 && samp && wid_i >= 4) { const float* sp = P.in[I_STBS] + ((size_t)(b * 32 + hv) * 128) * 128 + half * 64 + 16 * smt + fr;
#pragma unroll
                for (int r = 0; r < 4; ++r) sacc[j][r] = sp[(size_t)(16 * j + 4 * fq + r) * 128]; }
            else sacc[j] = (f32x4){0.f, 0.f, 0.f, 0.f};
            u32x2 w; w.x = cvt_pk_bf16(sacc[j][0], sacc[j][1]); w.y = cvt_pk_bf16(sacc[j][2], sacc[j][3]);
            if (ROLE == 1 && wid_i >= 4) *(LAS u32x2*)(ST + (16 * smt + fr) * 136 + 16 * j + 4 * fq) = w;
          } }
        unsigned pq[10], pk[10], pd[10], pv[5]; float pgc = 0.f, pbeta = 0.f;
        unsigned rq[10], rk[10], rv[13]; float rbeta = 0.f, rg = 0.f;
#define DR_LOADRAW(nn) do { if constexpr (ROLE == 1 && !(SKIP & 2)) { const int lane = launder_v(lane0), wq_ = launder_s(wid0) - 1; \
            const int cq = hk * 128 + 2 * lane, ck = 2048 + hk * 128 + 2 * lane, cvv = 4096 + hv * 128 + half * 64 + lane; \
            const float* bap = BA + (size_t)(rowbase + (nn) * 64 + lane) * 64; rbeta = bap[hv]; rg = bap[32 + hv]; \
            const int t0 = wq_ == 0 ? 0 : 1 + 9 * wq_, cnt = wq_ == 0 ? 10 : 9, p0 = (nn) * 64 + t0 - 3; \
            _Pragma("unroll") for (int i = 0; i < 13; ++i) { const int p = p0 + i; \
                if (p >= 0 && i - 3 < cnt) { const unsigned so_ = (unsigned)(rowbase + p) * (unsigned)(DNC * 2);     \
                    if (i >= 3) { rq[i - 3] = __builtin_amdgcn_raw_buffer_load_b32(rsrc_, 2 * cq, so_, 0); rk[i - 3] = __builtin_amdgcn_raw_buffer_load_b32(rsrc_, 2 * ck, so_, 0); } \
                    rv[i] = (unsigned)(unsigned short)__builtin_amdgcn_raw_buffer_load_b16(rsrc_, 2 * cvv, so_, 0); } \
                else if (p < 0 && samp) { const float* hp = histB + ((size_t)b * 3 + (3 + p)) * DNC; rv[i] = (unsigned)f2bf(hp[cvv]); } \
                else { rv[i] = 0u; if (i >= 3) { rq[i - 3] = 0u; rk[i - 3] = 0u; } } } } } while (0)
#define DR_PRECOMPUTE(nn) do { if constexpr (ROLE == 1 && !(SKIP & 2)) { const int lane = launder_v(lane0), wq_ = launder_s(wid0) - 1; \
            pbeta = rbeta; float g_ = rg; \
            _Pragma("unroll") for (int d = 1; d < 64; d <<= 1) { const float v_ = __shfl_up(g_, d); if (lane >= d) g_ += v_; } \
            pgc = g_; const float gl_ = __int_as_float(__builtin_amdgcn_readlane(__float_as_int(g_), 63)); \
            float wvv[4]; \
            _Pragma("unroll") for (int j = 0; j < 4; ++j) wvv[j] = CW[(j * 5 + 4) * 64 + lane]; \
            const int t0 = wq_ == 0 ? 0 : 1 + 9 * wq_; \
            float xv[13]; unsigned cq_[10], ck_[10]; \
            _Pragma("unroll") for (int i = 0; i < 13; ++i) xv[i] = bflo(rv[i]); \
            _Pragma("unroll") for (int i = 0; i < 10; ++i) { cq_[i] = rq[i]; ck_[i] = rk[i]; } \
            if ((nn) + 1 < nchunks) DR_LOADRAW((nn) + 1);                             \
            _Pragma("unroll") for (int i = 0; i < 10; ++i) { \
                float v = 0.f; \
                _Pragma("unroll") for (int j = 0; j < 4; ++j) v += wvv[j] * xv[i + j]; \
                v = siluf_(v); \
                const float k0 = bflo(ck_[i]), k1 = bfhi(ck_[i]); \
                const int tt = t0 + i < 64 ? t0 + i : 63; const float gt_ = __int_as_float(__builtin_amdgcn_readlane(__float_as_int(g_), tt)), bt_ = __int_as_float(__builtin_amdgcn_readlane(__float_as_int(pbeta), tt)); \
                const float kd = __expf(gl_ - gt_); \
                pq[i] = cq_[i]; pk[i] = ck_[i]; pd[i] = cvt_pk_bf16(k0 * kd, k1 * kd); \
                if (i & 1) pv[i >> 1] |= ((unsigned)f2bf(v * bt_)) << 16; else pv[i >> 1] = (unsigned)f2bf(v * bt_); } } } while (0)
        __syncthreads();
        DR_LOADRAW(0);
        DR_PRECOMPUTE(0);
        __syncthreads();
        for (int n = 0; n < nchunks; ++n) {
            const int crow = rowbase + n * 64;
            if constexpr (ROLE == 1) { const int lane = launder_v(lane0), wq_ = launder_s(wid0) - 1, t0 = wq_ == 0 ? 0 : 1 + 9 * wq_, cnt = wq_ == 0 ? 10 : 9;
                if (wq_ == 0) { const float eg_ = __expf(pgc); GC[lane] = pgc; BETA[lane] = pbeta; EG[lane] = eg_; BEG[lane] = pbeta * eg_; }
#pragma unroll
                for (int i = 0; i < 10; ++i) { const int t = t0 + i;
                    if (i < cnt) { *(LAS unsigned*)(QN + t * 136 + 2 * lane) = pq[i]; *(LAS unsigned*)(KN + t * 136 + 2 * lane) = pk[i];
                        KDT[(2 * lane) * 72 + t] = (bf16_t)(pd[i] & 0xffffu); KDT[(2 * lane + 1) * 72 + t] = (bf16_t)(pd[i] >> 16);
                        VBT[lane * 72 + t] = (bf16_t)((i & 1) ? (pv[i >> 1] >> 16) : (pv[i >> 1] & 0xffffu)); } }
            }
            __syncthreads();
            DR_DUMP(0);
            if constexpr (!(SKIP & 4)) { const int lane = launder_v(lane0), wid = launder_s(wid0), fr = lane & 15, fq = lane >> 4;
#pragma unroll
            for (int e = 0; e < 2; ++e) {
                const int id = 2 * wid + e, mt = id >> 2, nt = id & 3, i = 16 * mt + fr, j0 = 16 * nt + 4 * fq;
                f32x4 la = (f32x4){0.f, 0.f, 0.f, 0.f}, aa = (f32x4){0.f, 0.f, 0.f, 0.f};
                if (nt <= mt) {
                    la = tile_mma<128>(KN, 136, KN, 136, 16 * mt, 16 * nt, la, fr, fq);
                    aa = tile_mma<128>(QN, 136, KN, 136, 16 * mt, 16 * nt, aa, fr, fq);
                    const float gi = GC[i], bi = BETA[i];
#pragma unroll
                    for (int r = 0; r < 4; ++r) { const int j = j0 + r; const float dec = j <= i ? __expf(gi - GC[j]) : 0.f; aa[r] *= dec; la[r] = j < i ? la[r] * dec * bi : 0.f; }
                    if (nt == mt) {
#pragma unroll
                        for (int r = 0; r < 4; ++r) LD[(mt * 16 + fr) * 17 + 4 * fq + r] = la[r]; }
                }
                u32x2 w; w.x = cvt_pk_bf16(la[0], la[1]); w.y = cvt_pk_bf16(la[2], la[3]); *(LAS u32x2*)(LB + i * 72 + j0) = w;
                w.x = cvt_pk_bf16(aa[0], aa[1]); w.y = cvt_pk_bf16(aa[2], aa[3]); *(LAS u32x2*)(AI + i * 72 + j0) = w;
                { const int dv = 16 * mt + fr; f32x4 ra = (f32x4){0.f, 0.f, 0.f, 0.f};
                  ra = tile_mma<128>(ST, 136, KN, 136, 16 * mt, 16 * nt, ra, fr, fq);
                  const u32x2 vb = *(const LAS u32x2*)(VBT + dv * 72 + j0);
                  w.x = cvt_pk_bf16(bflo(vb.x) - BEG[j0] * ra[0], bfhi(vb.x) - BEG[j0 + 1] * ra[1]); w.y = cvt_pk_bf16(bflo(vb.y) - BEG[j0 + 2] * ra[2], bfhi(vb.y) - BEG[j0 + 3] * ra[3]);
                  *(LAS u32x2*)(RT + dv * 72 + j0) = w; }
            } }
            __syncthreads();
            DR_DUMP(1);
            if constexpr (ROLE == 1) { if (n + 1 < nchunks) DR_PRECOMPUTE(n + 1); }
            else if constexpr (!(SKIP & 1)) {
                const int lane = launder_v(lane0), fr = lane & 15, fq = lane >> 4, bk = lane >> 4, c = lane & 15;
                float x[16];
#pragma unroll
                for (int i = 0; i < 16; ++i) { float a = (i == c) ? 1.0f : 0.f;
#pragma unroll
                    for (int j = 0; j < i; ++j) a -= LD[(bk * 16 + i) * 17 + j] * x[j];
                    x[i] = a; }
#pragma unroll
                for (int i = 0; i < 16; ++i) TB[(16 * bk + i) * 72 + 16 * bk + c] = f2bf(x[i]);
#pragma unroll
                for (int i = 0; i < 16; i += 2) *(LAS unsigned*)(TT + (16 * bk + c) * 72 + 16 * bk + i) = cvt_pk_bf16(x[i], x[i + 1]);
                { const int zr = 16 + (lane >> 2), zc = 4 * (lane & 3); *(LAS u32x2*)(TT + zr * 72 + zc) = (u32x2){0u, 0u}; }
                asm volatile("s_waitcnt lgkmcnt(0)" ::: "memory");
#pragma unroll
                for (int p = 0; p < 2; ++p) { const int lo = 32 * p, hi = 32 * p + 16;
                    f32x4 a = (f32x4){0.f, 0.f, 0.f, 0.f};
                    a = tile_mma16(LB + hi * 72 + lo, 72, TT + lo * 72 + lo, 72, a, fr, fq);
#pragma unroll
                    for (int r = 0; r < 4; ++r) PT[(16 * p + 4 * fq + r) * 40 + fr] = f2bf(a[r]);
                }
                asm volatile("s_waitcnt lgkmcnt(0)" ::: "memory");
#pragma unroll
                for (int p = 0; p < 2; ++p) { const int lo = 32 * p, hi = 32 * p + 16;
                    f32x4 a = (f32x4){0.f, 0.f, 0.f, 0.f};
                    a = tile_mma16(TB + hi * 72 + hi, 72, PT + (16 * p) * 40, 40, a, fr, fq);
                    u32x2 w; w.x = cvt_pk_bf16(-a[0], -a[1]); w.y = cvt_pk_bf16(-a[2], -a[3]); *(LAS u32x2*)(TB + (hi + fr) * 72 + lo + 4 * fq) = w;
#pragma unroll
                    for (int r = 0; r < 4; ++r) TT[(lo + 4 * fq + r) * 72 + hi + fr] = f2bf(-a[r]);
                }
                asm volatile("s_waitcnt lgkmcnt(0)" ::: "memory");
#pragma unroll
                for (int mt = 0; mt < 2; ++mt)
#pragma unroll
                    for (int nt = 0; nt < 2; ++nt) { f32x4 a = (f32x4){0.f, 0.f, 0.f, 0.f};
                        a = tile_mma<32>(LB + 32 * 72, 72, TT, 72, 16 * mt, 16 * nt, a, fr, fq);
#pragma unroll
                        for (int r = 0; r < 4; ++r) PT[(16 * nt + 4 * fq + r) * 40 + 16 * mt + fr] = f2bf(a[r]); }
                asm volatile("s_waitcnt lgkmcnt(0)" ::: "memory");
#pragma unroll
                for (int mt = 0; mt < 2; ++mt)
#pragma unroll
                    for (int nt = 0; nt < 2; ++nt) { f32x4 a = (f32x4){0.f, 0.f, 0.f, 0.f};
                        a = tile_mma<32>(TB + 32 * 72 + 32, 72, PT, 40, 16 * mt, 16 * nt, a, fr, fq);
                        u32x2 w; w.x = cvt_pk_bf16(-a[0], -a[1]); w.y = cvt_pk_bf16(-a[2], -a[3]); *(LAS u32x2*)(TB + (32 + 16 * mt + fr) * 72 + 16 * nt + 4 * fq) = w; }
            }
            __syncthreads();
            DR_DUMP(2);
            if constexpr (!(SKIP & 8)) { const int lane = launder_v(lane0), wid = launder_s(wid0), fr = lane & 15, fq = lane >> 4;
#pragma unroll
            for (int e = 0; e < 2; ++e) {
                const int id = 2 * wid + e, mt = id >> 2, nt = id & 3, dv = 16 * mt + fr, t0 = 16 * nt + 4 * fq;
                f32x4 a = (f32x4){0.f, 0.f, 0.f, 0.f};
                a = tile_mma<64>(RT, 72, TB, 72, 16 * mt, 16 * nt, a, fr, fq);
                u32x2 w; w.x = cvt_pk_bf16(a[0], a[1]); w.y = cvt_pk_bf16(a[2], a[3]);
                *(LAS u32x2*)(VNT + dv * 72 + t0) = w;
            } }
            __syncthreads();
            DR_DUMP(4);
            if constexpr (!(SKIP & 8)) { const int lane = launder_v(lane0), wid = launder_s(wid0), fr = lane & 15, fq = lane >> 4;
#pragma unroll
            for (int e = 0; e < 2; ++e) {
                const int id = 2 * wid + e, mt = id >> 2, nt = id & 3, i = 16 * mt + fr;
                f32x4 a = (f32x4){0.f, 0.f, 0.f, 0.f};
                a = tile_mma<128>(QN, 136, ST, 136, 16 * mt, 16 * nt, a, fr, fq);
                a = a * EG[i];
                a = tile_mma<64>(AI, 72, VNT, 72, 16 * mt, 16 * nt, a, fr, fq);
                u32x2 w; w.x = cvt_pk_bf16(a[0], a[1]); w.y = cvt_pk_bf16(a[2], a[3]);
                *(u32x2*)(ODR + (size_t)(crow + i) * DNV + hv * 128 + half * 64 + 16 * nt + 4 * fq) = w;
#ifdef DBG_DR_DUMP
                if (item == 8 && n == 0) *(f32x4*)((float*)(ws + WS_END + 5 * (size_t)DR_END) + i * 64 + 16 * nt + 4 * fq) = a;
#endif
            }
            { const float dl = EG[63];
              if (ROLE == 1 && wid >= 4) {
#pragma unroll
              for (int j = 0; j < 8; ++j) { sacc[j] = sacc[j] * dl; sacc[j] = tile_mma<64>(VNT, 72, KDT, 72, 16 * smt, 16 * j, sacc[j], fr, fq); } } }
            __syncthreads();
#pragma unroll
            for (int j = 0; j < 8; ++j) { u32x2 w; w.x = cvt_pk_bf16(sacc[j][0], sacc[j][1]); w.y = cvt_pk_bf16(sacc[j][2], sacc[j][3]); if (ROLE == 1 && wid >= 4) *(LAS u32x2*)(ST + (16 * smt + fr) * 136 + 16 * j + 4 * fq) = w; }
            }
        }
        __syncthreads();
        { const int fr = lane_i & 15, fq = lane_i >> 4;
        if (ROLE == 1 && wid_i >= 4) {
#pragma unroll
        for (int j = 0; j < 8; ++j)
#pragma unroll
            for (int r = 0; r < 4; ++r) ssm_out[(size_t)(16 * j + 4 * fq + r) * 128 + half * 64 + 16 * smt + fr] = sacc[j][r];
        } }
#undef DR_PRECOMPUTE
#undef DR_LOADRAW
        };
        if (wid0 < 1) run_item(std::integral_constant<int, 0>{}); else run_item(std::integral_constant<int, 1>{});
        __syncthreads();
    }
}

__device__ __forceinline__ void phase_eb(const Params& P, int wv) {
    unsigned char* ws = P.ws; bf16_t* ODR = (bf16_t*)(ws + AR_ODR); const bf16_t* Z = (const bf16_t*)(ws + AR_Z); const float* go = P.in[I_GBOUT];
    const int tid_ = fresh_tid(wv), lane = tid_ & 63, gw = blockIdx.x * 8 + (tid_ >> 6), nw = gridDim.x * 8;
    float g[8];
#pragma unroll
    for (int e = 0; e < 8; ++e) g[e] = go[(lane & 15) * 8 + e];
    for (int row = gw; row < MT; row += nw) {
#pragma unroll
        for (int it = 0; it < 8; ++it) {
            const size_t off = (size_t)row * DNV + (it * 64 + lane) * 8;
            float o[8], z[8]; ld8(ODR + off, o); ld8(Z + off, z);
            float sq = 0.f;
#pragma unroll
            for (int e = 0; e < 8; ++e) sq += o[e] * o[e];
            sq += __shfl_xor(sq, 1); sq += __shfl_xor(sq, 2); sq += __shfl_xor(sq, 4); sq += __shfl_xor(sq, 8);
            const float rs = rsqrtf(sq * (1.0f / 128.0f) + EPS);
#pragma unroll
            for (int e = 0; e < 8; ++e) o[e] = o[e] * rs * g[e] * siluf_(z[e]);
            u32x4 w; w.x = cvt_pk_bf16(o[0], o[1]); w.y = cvt_pk_bf16(o[2], o[3]); w.z = cvt_pk_bf16(o[4], o[5]); w.w = cvt_pk_bf16(o[6], o[7]);
            *(u32x4*)(ODR + off) = w;
        }
    }
}
constexpr int LDS_BYTES = 147456;
static_assert(DR_END + 16 <= LDS_BYTES && pg8::STAGE_BYTES + 16 <= LDS_BYTES, "lds");
#ifndef TAILK
#define TAILK true
#endif
constexpr int NPH = 1 + 4 * 13 + 1;

__global__ void __launch_bounds__(NTH, 2) mega(Params P0) {
    extern __shared__ __attribute__((aligned(16))) unsigned char lds_raw[];
    LAS unsigned char* lds = (LAS unsigned char*)lds_raw;
    unsigned char* ws0 = P0.ws;
    const int wv = __builtin_amdgcn_readfirstlane((int)threadIdx.x >> 6);
    volatile LAS unsigned* xbw = (volatile LAS unsigned*)(lds + LDS_BYTES - 16);
    if (threadIdx.x == 0) { xbw[0] = 0u; xbw[1] = 0u; xbw[2] = 0u; xbw[3] = 0u; }
    __syncthreads();
    XcdBarrier bar = xcd_barrier_post((unsigned*)(ws0 + WS_CTL), xbw);
#define SSV(k) (SS + (size_t)(k) * MT)
    bool need_bar = false;
    int hbsel = 0;
    int ph = 0;
#define PHASE_BEGIN(active) if ((active) && ph >= P0.pb && ph < P0.pe) { if (need_bar) xcd_barrier(bar, wv); need_bar = true; asm volatile("; === PHASE SITE line %0" :: "n"(__LINE__)); const Params& P = P0; unsigned char* ws = P.ws; asm volatile("" : "+s"(ws)); \
        float* H = (float*)(ws + WS_H); bf16_t* HB = (bf16_t*)(ws + WS_HB + (size_t)(hbsel & 1) * HB_STRIDE); bf16_t* HBN = (bf16_t*)(ws + WS_HB + (size_t)((hbsel + 1) & 1) * HB_STRIDE); (void)HBN; ssq_t* SS = (ssq_t*)(ws + WS_SS); const int G = launder_s((int)gridDim.x), wg = launder_s((int)blockIdx.x); (void)H; (void)HB; (void)SS; (void)G; (void)wg;
#define PHASE_END } ++ph;

#ifndef REPEAT
#define REPEAT -1
#endif
#define REP(k, ...) do { if (REPEAT == (k)) { xcd_barrier(bar, wv); __VA_ARGS__; } } while (0)
    PHASE_BEGIN(true) phase_prologue(P, wv, lds); REP(0, phase_prologue(P, wv, lds)); if (REPEAT == 99) { for (int i_ = 0; i_ < 32; ++i_) xcd_barrier(bar, wv); } PHASE_END

    for (int L = 0; L < 4; ++L) {
        hbsel = L;
        const int kind = L % 3, ja = L / 3;
        PHASE_BEGIN(kind == 0) {
            pg8::Gemm g{HB, (const bf16_t*)(ws + WS_WAIN) + (size_t)ja * 6144 * 2048, MT, 6144, 2048};
            pg8::StaticOrder S; S.init(MT, 6144, 2048, G, wg, false);
            EpiA1 E{SSV(3 * L), (bf16_t*)(ws + AR_BG), (bf16_t*)(ws + AR_CV), P.out + O_PA + (size_t)ja * NBP * 2 * DM, P.out + O_SA + (size_t)ja * NBS * 2 * DM};
            pg8::gemm_phase(lds, g, S, E, wv);
            if (L == 0) REP(1, pg8::gemm_phase(lds, g, S, E, wv));
            if (L == 0) REP(11, pg8::gemm_phase(lds, g, S, EpiNull{}, wv));
            if (L == 0) REP(12, { pg8::Gemm g2 = g; g2.bmul = 0; pg8::gemm_phase(lds, g2, S, EpiNull{}, wv); });
            if (L == 0) REP(13, { pg8::Gemm g2 = g; g2.bmul = 0; g2.amul = 0; pg8::gemm_phase(lds, g2, S, EpiNull{}, wv); });
#define RX_(...) { xcd_barrier(bar, wv); pg8::gemm_phase(lds, g, S, E, wv); __VA_ARGS__; }
            if (L == 0 && REPEAT == 21) { RX_() RX_() RX_() RX_() }
            if (L == 0 && REPEAT == 25) { for (int r_ = 0; r_ < 8; ++r_) { xcd_barrier(bar, wv); prep_fill<1>(P, wv, lds, S.nwg, launder_s(G), launder_s(wg)); } }
            if (L == 0 && REPEAT == 22) { RX_(prep_fill<99>(P, wv, lds, S.nwg, launder_s(G), launder_s(wg))) RX_(prep_fill<99>(P, wv, lds, S.nwg, launder_s(G), launder_s(wg))) RX_(prep_fill<99>(P, wv, lds, S.nwg, launder_s(G), launder_s(wg))) RX_(prep_fill<99>(P, wv, lds, S.nwg, launder_s(G), launder_s(wg))) }
#undef RX_
            if (L == 0) prep_fill<1>(P, wv, lds, S.nwg, launder_s(G), launder_s(wg)); else prep_fill<7>(P, wv, lds, S.nwg, launder_s(G), launder_s(wg));
        } PHASE_END
        PHASE_BEGIN(kind != 0) {
            pg8::Gemm g; pg8::StaticOrder S; EpiRowScale E;
            if (kind == 1) { g = pg8::Gemm{HB, (const bf16_t*)(ws + WS_WBIN), MT, 12288, 2048};
                E = EpiRowScale{SSV(3 * L), (bf16_t*)(ws + AR_QKVP), DNC, DNC, (bf16_t*)(ws + AR_Z), DNV, 3, DNC, P.out + O_PBC, P.out + O_SBC, (bf16_t*)(ws + AR_HALO)}; }
            else { g = pg8::Gemm{HB, (const bf16_t*)(ws + WS_WCQKV), MT, 6144, 2048};
                E = EpiRowScale{SSV(3 * L), (bf16_t*)(ws + AR_QKV), 6144, 1 << 30, nullptr, 0, 0, 0, nullptr, nullptr, nullptr}; }
            S.init(MT, g.N, 2048, G, wg, false);
            pg8::gemm_phase(lds, g, S, E, wv);
            if (kind == 1) prep_fill<3>(P, wv, lds, S.nwg, launder_s(G), launder_s(wg)); else prep_fill<5>(P, wv, lds, S.nwg, launder_s(G), launder_s(wg));
        } PHASE_END
        PHASE_BEGIN(kind == 1) { phase_ba(P, wv, SSV(3 * L), HB); phase_qkn(P, wv); } PHASE_END
        PHASE_BEGIN(true) {
            if (kind == 0) { phase_ea(P, wv, ja); if (L == 0) REP(2, phase_ea(P, wv, ja)); }
            else if (kind == 1) {
#if REPEAT >= 30 && REPEAT < 46
                phase_dr<REPEAT - 30>(P, wv, lds); xcd_barrier(bar, wv);
#endif
                phase_dr(P, wv, lds); REP(3, phase_dr(P, wv, lds)); }
            else phase_ec(P, wv, lds);
        } PHASE_END
        PHASE_BEGIN(kind != 0) {
            if (kind == 1) phase_eb(P, wv);
            else { phase_att(P, wv, lds); phase_att_sample(P, wv); REP(4, { phase_att(P, wv, lds); phase_att_sample(P, wv); }); }
        } PHASE_END
        PHASE_BEGIN(true) {
            pg8::Gemm g;
            if (kind == 0) g = pg8::Gemm{(const bf16_t*)(ws + AR_AA), (const bf16_t*)(ws + WS_WAOUT) + (size_t)ja * 2048 * 2048, MT, 2048, 2048};
            else if (kind == 1) g = pg8::Gemm{(const bf16_t*)(ws + AR_ODR), (const bf16_t*)(ws + WS_WBOUT), MT, 2048, 4096};
            else g = pg8::Gemm{(const bf16_t*)(ws + AR_OATT), (const bf16_t*)(ws + WS_WCOUT), MT, 2048, 2048};
            pg8::StaticOrder S; S.init(MT, 2048, g.K, G, wg, TAILK);
            EpiResid<false> E{H, HB, HB, SSV(3 * L + 1), nullptr, nullptr};
            pg8::gemm_phase(lds, g, S, E, wv, (float*)(ws + (kind != 0 ? AR_PART_B : AR_PART)));
        } PHASE_END
        PHASE_BEGIN(TAILK) phase_reduce(P, wv, kind == 1 ? 4096 : 2048, (const float*)(ws + (kind != 0 ? AR_PART_B : AR_PART)), SSV(3 * L + 1), nullptr, HB, HB); PHASE_END
        PHASE_BEGIN(true) {
            pg8::Gemm g{HB, (const bf16_t*)(ws + WS_WFUP) + (size_t)L * DFF2 * 2048, MT, DFF2, 2048};
            pg8::StaticOrder S; S.init(MT, DFF2, 2048, G, wg, false);
            EpiGlu E{SSV(3 * L + 1), (bf16_t*)(ws + AR_ACT), (float*)(ws + AR_XB), P.in[I_WFCONV] + (size_t)L * 3 * DFF2, P.in[I_BFCONV] + (size_t)L * DFF2, P.out + O_PF + (size_t)L * NBP * 2 * DFF2, P.out + O_SF + (size_t)L * NBS * 2 * DFF2};
            pg8::gemm_phase(lds, g, S, E, wv);
            if (L == 0) REP(5, pg8::gemm_phase(lds, g, S, E, wv));
            if (L == 0) REP(15, pg8::gemm_phase(lds, g, S, EpiNull{}, wv));
#define RX_(...) { xcd_barrier(bar, wv); pg8::gemm_phase(lds, g, S, E, wv); __VA_ARGS__; }
            if (L == 0 && REPEAT == 23) { RX_() RX_() RX_() RX_() }
            if (L == 0 && REPEAT == 24) { RX_(prep_fill<2>(P, wv, lds, S.nwg, launder_s(G), launder_s(wg))) RX_(prep_fill<2>(P, wv, lds, S.nwg, launder_s(G), launder_s(wg))) RX_(prep_fill<2>(P, wv, lds, S.nwg, launder_s(G), launder_s(wg))) RX_(prep_fill<2>(P, wv, lds, S.nwg, launder_s(G), launder_s(wg))) }
#undef RX_
            { const int G2 = launder_s(G), wg2 = launder_s(wg);
              if (L == 0) prep_fill<2>(P, wv, lds, S.nwg, G2, wg2); else if (L == 1) prep_fill<4>(P, wv, lds, S.nwg, G2, wg2); else if (L == 2) prep_fill<6>(P, wv, lds, S.nwg, G2, wg2); else prep_fill<8>(P, wv, lds, S.nwg, G2, wg2); }
        } PHASE_END
        PHASE_BEGIN(true) phase_ef(P, wv, L); if (L == 0) REP(6, phase_ef(P, wv, L)); PHASE_END
        PHASE_BEGIN(true) {
            { pg8::Gemm g{(const bf16_t*)(ws + AR_ACT), (const bf16_t*)(ws + WS_WFDOWN) + (size_t)L * 2048 * DFF, MT, 2048, DFF};
              pg8::StaticOrder S; S.init(MT, 2048, DFF, G, wg, TAILK);
              EpiResid<false> E{H, HB, HB, SSV(3 * L + 2), nullptr, nullptr};
              pg8::gemm_phase(lds, g, S, E, wv, (float*)(ws + AR_PART)); }
            { unsigned char* ws2 = ws; asm volatile("" : "+s"(ws2)); const int G2 = launder_s(G), wg2 = launder_s(wg);
              pg8::Gemm g{(const bf16_t*)(ws2 + WS_PB) + (size_t)L * MT * PLE, (const bf16_t*)(ws2 + WS_WPP) + (size_t)L * 2048 * PLE, MT, 2048, launder_s(PLE)};
              pg8::StaticOrder S; S.init(MT, 2048, PLE, G2, G2 - 1 - wg2, false);
              EpiPlain E{(bf16_t*)(ws2 + AR_PPB), DM};
              pg8::gemm_phase(lds, g, S, E, wv); }
        } PHASE_END
        PHASE_BEGIN(TAILK) phase_reduce(P, wv, DFF, (const float*)(ws + AR_PART), SSV(3 * L + 2), nullptr, HB, HB); PHASE_END
        PHASE_BEGIN(true) {
            pg8::Gemm g{HB, (const bf16_t*)(ws + WS_WPG) + (size_t)L * 2048 * 2048, MT, 2048, 2048};
            pg8::StaticOrder S; S.init(MT, 2048, 2048, G, wg, TAILK);
            EpiResid<true> E{H, HB, HBN, SSV(3 * L + 3), SSV(3 * L + 2), (const bf16_t*)(ws + AR_PPB)};
            pg8::gemm_phase(lds, g, S, E, wv, (float*)(ws + AR_PART));
        } PHASE_END
        PHASE_BEGIN(TAILK) phase_reduce(P, wv, 2048, (const float*)(ws + AR_PART), SSV(3 * L + 3), SSV(3 * L + 2), HB, HBN); PHASE_END
    }
    hbsel = 4;
    PHASE_BEGIN(true) phase_final(P, wv, HB); REP(7, phase_final(P, wv, HB)); PHASE_END
#undef PHASE_BEGIN
#undef PHASE_END
}
extern "C" void kernel_launch(void* const* d_in, const int* in_sizes, int n_in, void* d_out, int out_size, void* d_ws, size_t ws_size, hipStream_t stream) {
    static int grid = 0;
    if (grid == 0) {
        if (n_in != N_IN || out_size != (int)O_END || ws_size < WS_NEED) { fprintf(stderr, "kernel_launch: unexpected problem: n_in %d out %d ws %zu (need %zu)\n", n_in, out_size, ws_size, (size_t)WS_NEED); grid = -1; return; }
        int dev = 0, cus = 0;
        if (hipGetDevice(&dev) != hipSuccess || hipDeviceGetAttribute(&cus, hipDeviceAttributeMultiprocessorCount, dev) != hipSuccess) { grid = -1; return; }
        if (hipFuncSetAttribute((const void*)mega, hipFuncAttributeMaxDynamicSharedMemorySize, LDS_BYTES) != hipSuccess) { fprintf(stderr, "kernel_launch: hipFuncSetAttribute failed\n"); grid = -1; return; }
        int per_cu = 0;
        if (hipOccupancyMaxActiveBlocksPerMultiprocessor(&per_cu, (const void*)mega, NTH, LDS_BYTES) != hipSuccess || per_cu < 1) { fprintf(stderr, "kernel_launch: occupancy query says %d\n", per_cu); grid = -1; return; }
        grid = cus;
    }
    if (grid <= 0) return;
    (void)hipMemsetAsync((char*)d_ws + WS_CTL, 0, CTL_BYTES, stream);
    Params p{};
    for (int i = 0; i < N_IN; ++i) p.in[i] = (const float*)d_in[i];
    p.out = (float*)d_out; p.ws = (unsigned char*)d_ws;
#ifndef DBG
    p.pb = 0; p.pe = NPH;
    hipLaunchKernelGGL(mega, dim3(grid), dim3(NTH), LDS_BYTES, stream, p);
#else
    dbg_run(p, grid, stream);
#endif
}
```

```cpp
#include <hip/hip_runtime.h>
#include <cstdio>
#include <cstdint>

#define LAS __attribute__((address_space(3)))
typedef unsigned short bf16_t;
typedef short bf16x8 __attribute__((ext_vector_type(8)));
typedef float f32x4 __attribute__((ext_vector_type(4)));
typedef float f32x2 __attribute__((ext_vector_type(2)));
typedef unsigned u32x4 __attribute__((ext_vector_type(4)));
typedef unsigned u32x2 __attribute__((ext_vector_type(2)));

constexpr int DM = 2048, SEQ = 4096, DSEQ = 64, NBP = 4, NBS = 16;
constexpr int MP = NBP * SEQ, MS = NBS * DSEQ, MT = MP + MS;
constexpr int DFF = 5632, DFF2 = 11264, PLE = 256;
constexpr int DNC = 8192, DNV = 4096, DNIN = 12352;
constexpr int NTH = 512;
constexpr float EPS = 1e-6f;

enum { I_XP = 0, I_XS, I_STA, I_STBC, I_STBS, I_CK, I_CV, I_STF, I_PP, I_PS, I_GMIX, I_GFFN, I_WAIN, I_WACONV, I_WAOUT, I_WBIN, I_WBCONV, I_ALOG, I_DTB, I_GBOUT, I_WBOUT,
       I_WCQKV, I_GCQ, I_GCK, I_RELB, I_WCOUT, I_WFUP, I_WFCONV, I_BFCONV, I_WFDOWN, I_GPLE, I_WPG, I_WPP, I_GFIN, N_IN };

constexpr size_t O_YP = 0, O_YS = O_YP + (size_t)MP * DM, O_PA = O_YS + (size_t)MS * DM, O_PBC = O_PA + 2 * 4 * 2 * 2048, O_PBS = O_PBC + 4 * 3 * 8192,
                 O_PCK = O_PBS + (size_t)4 * 32 * 128 * 128, O_PCV = O_PCK + (size_t)4 * 512 * 2048, O_PF = O_PCV + (size_t)4 * 512 * 2048, O_SA = O_PF + 4 * 4 * 2 * 11264,
                 O_SBC = O_SA + 2 * 16 * 2 * 2048, O_SBS = O_SBC + 16 * 3 * 8192, O_SCK = O_SBS + (size_t)16 * 32 * 128 * 128, O_SCV = O_SCK + (size_t)16 * 64 * 2048,
                 O_SF = O_SCV + (size_t)16 * 64 * 2048, O_END = O_SF + 4 * 16 * 2 * 11264;
static_assert(O_END == 61177856, "output size");

constexpr size_t al256(size_t x) { return (x + 255) & ~(size_t)255; }
constexpr size_t WS_CTL = 0;
constexpr size_t CTL_BYTES = 65536;
constexpr size_t WS_SS = WS_CTL + CTL_BYTES;
constexpr int NSS = 13;
constexpr size_t SS_BYTES = al256((size_t)NSS * MT * 8);
constexpr size_t ZERO_BYTES = CTL_BYTES + SS_BYTES;
constexpr size_t WS_BA = WS_SS + SS_BYTES;
constexpr size_t WS_WAIN = WS_BA + (size_t)MT * 64 * 4;
constexpr size_t WS_WAOUT = WS_WAIN + (size_t)2 * 6144 * 2048 * 2;
constexpr size_t WS_WBIN = WS_WAOUT + (size_t)2 * 2048 * 2048 * 2;
constexpr size_t WS_WBBA = WS_WBIN + (size_t)12288 * 2048 * 2;
constexpr size_t WS_WBOUT = WS_WBBA + (size_t)64 * 2048 * 2;
constexpr size_t WS_WCQKV = WS_WBOUT + (size_t)2048 * 4096 * 2;
constexpr size_t WS_WCOUT = WS_WCQKV + (size_t)6144 * 2048 * 2;
constexpr size_t WS_WFUP = WS_WCOUT + (size_t)2048 * 2048 * 2;
constexpr size_t WS_WFDOWN = WS_WFUP + (size_t)4 * 11264 * 2048 * 2;
constexpr size_t WS_WPG = WS_WFDOWN + (size_t)4 * 2048 * 5632 * 2;
constexpr size_t WS_WPP = WS_WPG + (size_t)4 * 2048 * 2048 * 2;
constexpr size_t WS_H = WS_WPP + (size_t)4 * 2048 * 256 * 2;
constexpr size_t WS_HB = WS_H + (size_t)MT * DM * 4;
constexpr size_t HB_STRIDE = (size_t)MT * DM * 2;
constexpr size_t WS_PB = WS_HB + 2 * HB_STRIDE;
constexpr size_t WS_ARENA = WS_PB + (size_t)4 * MT * PLE * 2;
constexpr size_t AR_BG = WS_ARENA, AR_CV = AR_BG + (size_t)MT * DM * 2, AR_AA = AR_CV + (size_t)MT * DM * 2, AR_A_END = AR_AA + (size_t)MT * DM * 2;
constexpr size_t AR_QKVP = WS_ARENA, AR_Z = AR_QKVP + (size_t)MT * DNC * 2, AR_ODR = AR_Z + (size_t)MT * DNV * 2, AR_HALO = AR_ODR + (size_t)MT * DNV * 2, AR_B_END = AR_HALO + (size_t)(MT / 64) * 3 * 4096 * 2;
constexpr size_t AR_QKV = WS_ARENA, AR_VTP = AR_QKV + (size_t)MT * 6144 * 2, AR_VTS = AR_VTP + (size_t)4 * 16 * 128 * 4096 * 2, AR_KS = AR_VTS + (size_t)16 * 16 * 128 * 576 * 2,
                 AR_OATT = AR_KS + (size_t)16 * 576 * 2048 * 2, AR_C_END = AR_OATT + (size_t)MT * DM * 2;
constexpr size_t AR_ACT = WS_ARENA, AR_XB = AR_ACT + (size_t)MT * DFF * 2, AR_PPB = AR_XB + (size_t)(MT / 64) * 4 * DFF2 * 4, AR_F_END = AR_PPB + (size_t)MT * DM * 2;
constexpr size_t AR_PART = WS_ARENA + ((size_t)400 << 20), AR_PART_B = WS_ARENA, PART_BYTES = (size_t)256 * 65536 * 4;
constexpr size_t WS_END = AR_B_END > AR_F_END ? (AR_B_END > AR_C_END ? AR_B_END : AR_C_END) : (AR_F_END > AR_C_END ? AR_F_END : AR_C_END);
static_assert(AR_A_END <= WS_END && AR_B_END <= WS_END && AR_C_END <= WS_END && AR_F_END <= WS_END, "arena");
static_assert(AR_A_END <= AR_PART && AR_F_END <= AR_PART && AR_PART + PART_BYTES <= WS_END && AR_PART_B + PART_BYTES <= AR_ODR && AR_PART_B + PART_BYTES <= AR_VTP, "partials");
#ifdef DBG
constexpr size_t WS_HCOPY = WS_END;
constexpr size_t WS_NEED = WS_HCOPY + HB_STRIDE;
#else
constexpr size_t WS_NEED = WS_END;
#endif

struct Params { const float* in[N_IN]; float* out; unsigned char* ws; int pb, pe; };

__device__ __forceinline__ int launder_v(int v) { asm volatile("" : "+v"(v)); return v; }
__device__ __forceinline__ int launder_s(int v) { asm volatile("" : "+s"(v)); return v; }
__device__ __forceinline__ int fresh_tid(int wv) { unsigned z = 0u; asm volatile("" : "+v"(z));
    int t = wv * 64 + (int)__builtin_amdgcn_mbcnt_hi(~0u, __builtin_amdgcn_mbcnt_lo(~0u, z)); asm volatile("" : "+v"(t)); return t; }
__device__ __forceinline__ const Params& fresh(const Params& P) { const Params* p = &P; asm volatile("" : "+s"(p)); return *p; }
__device__ __forceinline__ float bf2f(bf16_t v) { return __uint_as_float(((unsigned)v) << 16); }
__device__ __forceinline__ float bflo(unsigned w) { return __uint_as_float(w << 16); }
__device__ __forceinline__ float bfhi(unsigned w) { return __uint_as_float(w & 0xffff0000u); }
typedef __bf16 bf16x2_t __attribute__((ext_vector_type(2)));
__device__ __forceinline__ unsigned cvt_pk_bf16(float lo, float hi) { const bf16x2_t v = __builtin_convertvector((f32x2){lo, hi}, bf16x2_t); unsigned r; __builtin_memcpy(&r, &v, 4); return r; }
__device__ __forceinline__ bf16_t f2bf(float f) { return (bf16_t)(cvt_pk_bf16(f, 0.f) & 0xffffu); }
__device__ __forceinline__ float sigmoidf_(float x) { return __builtin_amdgcn_rcpf(1.0f + __expf(-x)); }
__device__ __forceinline__ float siluf_(float x) { return x * __builtin_amdgcn_rcpf(1.0f + __expf(-x)); }
#define DPPF(old, v, ctrl, rm) __int_as_float(__builtin_amdgcn_update_dpp(__float_as_int(old), __float_as_int(v), (ctrl), (rm), 0xf, false))
__device__ __forceinline__ float wave_sum(float v) {
    v += DPPF(0.f, v, 0xB1, 0xf);
    v += DPPF(0.f, v, 0x4E, 0xf);
    v += DPPF(0.f, v, 0x141, 0xf);
    v += DPPF(0.f, v, 0x140, 0xf);
    v += DPPF(0.f, v, 0x142, 0xa);
    v += DPPF(0.f, v, 0x143, 0xc);
    return __int_as_float(__builtin_amdgcn_readlane(__float_as_int(v), 63));
}
typedef unsigned long long ssq_t;
constexpr float SSQ_SCALE = 16777216.0f;
__device__ __forceinline__ ssq_t ssq_fix(float sq) { return (ssq_t)(sq * SSQ_SCALE + 0.5f); }
#ifndef WT_AUX
#define WT_AUX 2
#endif
__device__ __forceinline__ float rstd_of(const ssq_t* ss, int row) { return rsqrtf((float)ss[row] * (1.0f / (2048.0f * SSQ_SCALE)) + EPS); }
__device__ __forceinline__ void row_pos(int row, int& b, int& s, int& S) { if (row < MP) { b = row >> 12; s = row & 4095; S = SEQ; } else { const int rr = row - MP; b = rr >> 6; s = rr & 63; S = DSEQ; } }

#define XB_TMO      128
#define XB_XCNT(j)  (256  + 64 * (j))
#define XB_XSUB(j)  (1280 + 64 * (j))
#define XB_XGEN(j)  (2304 + 64 * (j))
#define XB_TOP      3328
#define XB_TOPGEN   3392
#define XCD_BAR_WORDS 3456
#define XB_SPIN_CAP (1u << 18)
__device__ __forceinline__ unsigned xb_ld(unsigned* p)              { return __hip_atomic_load(p, __ATOMIC_RELAXED, __HIP_MEMORY_SCOPE_AGENT); }
__device__ __forceinline__ unsigned xb_add(unsigned* p, unsigned v) { return __hip_atomic_fetch_add(p, v, __ATOMIC_RELAXED, __HIP_MEMORY_SCOPE_AGENT); }
__device__ __forceinline__ unsigned xb_xcc_id() { return (unsigned)__builtin_amdgcn_s_getreg((3 << 11) | 20) & 0xFu; }
#define XB_SPIN(cond, bar) do { unsigned _sp = 0; while (cond) { __builtin_amdgcn_s_sleep(1); \
    if ((++_sp & 255u) == 0u) { if (xb_ld(&(bar)[XB_TMO])) break; if (_sp > XB_SPIN_CAP) { atomicAdd(&(bar)[XB_TMO], 1u); break; } } } } while (0)
struct XcdBarrier { unsigned* bar; unsigned x; volatile LAS unsigned* st; };
__device__ __forceinline__ XcdBarrier xcd_barrier_post(unsigned* bar, volatile LAS unsigned* st) {
    XcdBarrier b; b.bar = bar; b.x = xb_xcc_id(); b.st = st;
    if (threadIdx.x == 0) (void)xb_add(&bar[XB_XCNT(b.x)], 1u);
    return b;
}
__device__ __forceinline__ void xcd_barrier_complete(unsigned* bar, unsigned x, unsigned& nloc, unsigned& nx) {
    const unsigned G = gridDim.x * gridDim.y * gridDim.z;
    unsigned sum, cnt, mine, sp = 0u;
    for (;;) {
        sum = 0u; cnt = 0u; mine = 0u;
#pragma unroll
        for (unsigned j = 0; j < 16; ++j) { const unsigned c = xb_ld(&bar[XB_XCNT(j)]); sum += c; cnt += (c > 0u) ? 1u : 0u; mine = (j == x) ? c : mine; }
        if (sum == G) break;
        __builtin_amdgcn_s_sleep(1);
        if ((++sp & 255u) == 0u) { if (xb_ld(&bar[XB_TMO])) break; if (sp > XB_SPIN_CAP) { atomicAdd(&bar[XB_TMO], 1u); break; } }
    }
    nloc = mine > 0u ? mine : 1u; nx = cnt > 0u ? cnt : 1u;
}
__device__ __forceinline__ void xcd_barrier(const XcdBarrier& b, int wv) {
    asm volatile("s_waitcnt vmcnt(0)" ::: "memory");
    __syncthreads();
    if (fresh_tid(wv) == 0) {
        unsigned* bar = b.bar;
        __builtin_amdgcn_s_waitcnt(0);
        unsigned nloc = b.st[0], nx = b.st[1];
        if (nloc == 0u) { xcd_barrier_complete(bar, b.x, nloc, nx); b.st[0] = nloc; b.st[1] = nx; }
        const unsigned old = xb_add(&bar[XB_XSUB(b.x)], 1u);
        const unsigned gen = old / nloc;
        if (old + 1u == (gen + 1u) * nloc) {
            __builtin_amdgcn_fence(__ATOMIC_RELEASE, "agent");
            asm volatile("s_waitcnt vmcnt(0)" ::: "memory");
            const unsigned og = xb_add(&bar[XB_TOP], 1u);
            const unsigned tg = og / nx;
            if (og + 1u == (tg + 1u) * nx) xb_add(&bar[XB_TOPGEN], 1u);
            else XB_SPIN(xb_ld(&bar[XB_TOPGEN]) == tg, bar);
            __builtin_amdgcn_fence(__ATOMIC_ACQUIRE, "agent");
            xb_add(&bar[XB_XGEN(b.x)], 1u);
            asm volatile("s_waitcnt vmcnt(0)" ::: "memory");
        } else {
            XB_SPIN(xb_ld(&bar[XB_XGEN(b.x)]) == gen, bar);
            __builtin_amdgcn_fence(__ATOMIC_ACQUIRE, "agent");
            asm volatile("s_waitcnt vmcnt(0)" ::: "memory");
        }
    }
    __syncthreads();
}
namespace pg8 {
constexpr int BM = 256, BK = 64, HALF = 128, HTB = HALF * BK * 2, STAGE_BYTES = 8 * HTB, NXCD = 8, WGM = 8;
__host__ __device__ __forceinline__ int lds_byte(int r, int c) { const int st = (r >> 4) * 2 + (c >> 5), rr = r & 15, cc = c & 31, ob = rr * 64 + cc * 2; return st * 1024 + (ob ^ (((ob >> 9) & 1) << 5)); }
__host__ __device__ __forceinline__ void stage_rc(int b, int& R, int& C) { const int st = b / 1024, sb = b % 1024, swz = sb ^ (((sb >> 9) & 1) << 5); R = (st >> 1) * 16 + swz / 64; C = (st & 1) * 32 + (swz % 64) / 2; }
__host__ __device__ __forceinline__ int perm32(int rho) { const int n = rho >> 4, i = rho & 15; return 8 * (i >> 2) + 4 * n + (i & 3); }
struct Unit { int pm, pn, k0, nt, part; };
struct Gemm { const bf16_t* A; const bf16_t* Bt; int M, N, K; int amul = 1, bmul = 1; };
struct StaticOrder {
    int nM, nN, nwg, G, c, KT, nreg;
    __device__ __forceinline__ void init(int M, int N, int K, int G_, int c_, bool tail) { nM = M / BM; nN = N / BM; nwg = nM * nN; G = G_; c = c_; KT = K / BK; nreg = nwg;
        if (tail) { const int rem = nwg % G; if (rem > 0 && rem * 8 == G && (KT / 8) >= 4) nreg = nwg - rem; } }
    __device__ __forceinline__ int map(int L) const {
        int wgid = L; { const int q = nwg / NXCD, r = nwg % NXCD, xcd = wgid % NXCD, off = wgid / NXCD; wgid = (xcd < r ? xcd * (q + 1) : r * (q + 1) + (xcd - r) * q) + off; }
        const int nig = WGM * nN, gid = wgid / nig, fm = gid * WGM, gsz = (nM - fm) < WGM ? (nM - fm) : WGM;
        return ((fm + ((wgid % nig) % gsz)) << 16) | ((wgid % nig) / gsz);
    }
    __device__ __forceinline__ bool next(int i, Unit& u) const {
        const long L = (long)i * G + c;
        const bool reg = L < nreg, tl = !reg && nreg < nwg && i == nreg / G;
        const int j = c >> 3, s = c & 7, q = KT >> 3;
        const int pq = map(reg ? (int)L : (tl ? nreg + j : 0));
        const int nt_t = (q & 1) ? ((s & 1) ? q - 1 : q + 1) : q, k0_t = ((q & 1) ? (s * q + (s & 1)) : s * q) * BK;
        u.pm = pq >> 16; u.pn = pq & 0xffff; u.k0 = reg ? 0 : k0_t; u.nt = reg ? KT : nt_t; u.part = reg ? -1 : j * 8 + s;
        return reg || tl;
    }
};
template <class Epi>
__device__ __forceinline__ void gemm_phase(LAS unsigned char* lds, const Gemm g, const StaticOrder& S, const Epi& E, int wv, float* PART = nullptr) {
    const int tid = fresh_tid(wv), wid = __builtin_amdgcn_readfirstlane(tid >> 6), lane = tid & 63, wr = wid >> 2, wc = wid & 3, fr = lane & 15, fq = lane >> 4;
    const int K = g.K;
    unsigned voffA[2], voffB[2];
#pragma unroll
    for (int i = 0; i < 2; ++i) { int R, C; stage_rc(tid * 16 + i * 8192, R, C); const int Rb = ((R & ~31) + perm32(R & 31));
        voffA[i] = (unsigned)(R * K + C) * 2u; voffB[i] = (unsigned)(Rb * K + C) * 2u; }
    const size_t kstep = (size_t)(BK * 2);
    const size_t hstep = (size_t)HALF * K * 2;
    const size_t tstep = 2 * hstep;
    const unsigned ldsw = (unsigned)wid * 1024u;
    const int aoff = lds_byte(wr * 64 + fr, fq * 8), boff = lds_byte(wc * 32 + fr, fq * 8);
#define PG8_SA(b, h) (((b) * 2 + (h)) * HTB)
#define PG8_SB(b, h) ((4 + (b) * 2 + (h)) * HTB)
#define PG8_STAGE(bufoff, gbase, voff) do { _Pragma("unroll") for (int _i = 0; _i < 2; ++_i) \
        __builtin_amdgcn_global_load_lds((const unsigned*)((const char*)(gbase) + (voff)[_i]), (LAS unsigned*)(lds + (bufoff) + ldsw + _i * 8192), 16, 0, 0); } while (0)
#define PG8_LDA(dst, b, h) do { _Pragma("unroll") for (int m = 0; m < 4; ++m) _Pragma("unroll") for (int k = 0; k < 2; ++k) dst[m][k] = *(const LAS bf16x8*)(lds + PG8_SA(b, h) + aoff + m * 2048 + k * 1024); } while (0)
#define PG8_LDB(dst, b, h) do { _Pragma("unroll") for (int n = 0; n < 2; ++n) _Pragma("unroll") for (int k = 0; k < 2; ++k) dst[n][k] = *(const LAS bf16x8*)(lds + PG8_SB(b, h) + boff + n * 2048 + k * 1024); } while (0)
#define PG8_MMA(ai, bj, At, Bt) do { __builtin_amdgcn_s_setprio(1); _Pragma("unroll") for (int m = 0; m < 4; ++m) _Pragma("unroll") for (int n = 0; n < 2; ++n) _Pragma("unroll") for (int k = 0; k < 2; ++k) \
        acc[ai][bj][m][n] = __builtin_amdgcn_mfma_f32_16x16x32_bf16(Bt[n][k], At[m][k], acc[ai][bj][m][n], 0, 0, 0); __builtin_amdgcn_s_setprio(0); } while (0)
#define PG8_WAIT_V(n) asm volatile("s_waitcnt vmcnt(" #n ")" ::: "memory")
#define PG8_WAIT_L(n) asm volatile("s_waitcnt lgkmcnt(" #n ")" ::: "memory")
#define PG8_BAR __builtin_amdgcn_s_barrier()
#define PG8_SCHED __builtin_amdgcn_sched_barrier(0)
    Unit cur, nxt; int ui = 0;
    if (!S.next(0, cur)) return;
    f32x4 acc[2][2][4][2];
#pragma unroll
    for (int a = 0; a < 2; ++a)
#pragma unroll
        for (int b = 0; b < 2; ++b)
#pragma unroll
            for (int m = 0; m < 4; ++m)
#pragma unroll
                for (int n = 0; n < 2; ++n) acc[a][b][m][n] = (f32x4){0.f, 0.f, 0.f, 0.f};
    bf16x8 At[4][2], B0[2][2], B1[2][2];
    const char* cA = (const char*)g.A + (size_t)(cur.pm * g.amul) * tstep + (size_t)cur.k0 * 2; const char* cB = (const char*)g.Bt + (size_t)(cur.pn * g.bmul) * tstep + (size_t)cur.k0 * 2;
    int nt = cur.nt;
#ifdef PG8_OLD
    PG8_STAGE(PG8_SB(0, 0), cB, voffB); PG8_STAGE(PG8_SA(0, 0), cA, voffA); PG8_STAGE(PG8_SB(0, 1), cB + hstep, voffB); PG8_STAGE(PG8_SA(0, 1), cA + hstep, voffA);
    if (wr == 1) PG8_BAR;
    PG8_WAIT_V(4); PG8_BAR;
    PG8_STAGE(PG8_SB(1, 0), cB + kstep, voffB); PG8_STAGE(PG8_SA(1, 0), cA + kstep, voffA); PG8_STAGE(PG8_SB(1, 1), cB + hstep + kstep, voffB);
    PG8_WAIT_V(6); PG8_BAR;
#else
    PG8_STAGE(PG8_SB(0, 0), cB, voffB); PG8_STAGE(PG8_SB(0, 1), cB + hstep, voffB); PG8_STAGE(PG8_SA(0, 0), cA, voffA); PG8_STAGE(PG8_SA(0, 1), cA + hstep, voffA);
    if (wr == 1) PG8_BAR;
    PG8_WAIT_V(2); PG8_BAR;
    PG8_STAGE(PG8_SB(1, 0), cB + kstep, voffB); PG8_STAGE(PG8_SA(1, 0), cA + kstep, voffA); PG8_STAGE(PG8_SB(1, 1), cB + hstep + kstep, voffB);
    PG8_WAIT_V(6); PG8_BAR;
#endif
    for (;;) {
        const bool has_next = S.next(ui + 1, nxt);
        const char* nA = has_next ? (const char*)g.A + (size_t)(nxt.pm * g.amul) * tstep + (size_t)nxt.k0 * 2 : cA; const char* nB = has_next ? (const char*)g.Bt + (size_t)(nxt.pn * g.bmul) * tstep + (size_t)nxt.k0 * 2 : cB;
        for (int t = 0; t < nt; t += 2) {
            const bool last = (t == nt - 2);
            const char* a1 = cA + (size_t)(t + 1) * kstep;
            const char* a2 = last ? nA : cA + (size_t)(t + 2) * kstep; const char* b2 = last ? nB : cB + (size_t)(t + 2) * kstep;
            const char* a3 = a2 + kstep; const char* b3 = b2 + kstep;
#ifdef PG8_OLD
            PG8_LDB(B0, 0, 0); PG8_SCHED; PG8_LDA(At, 0, 0); PG8_STAGE(PG8_SA(1, 1), a1 + hstep, voffA);
            PG8_WAIT_L(8); PG8_BAR; PG8_WAIT_L(0); PG8_MMA(0, 0, At, B0); PG8_BAR; PG8_SCHED;
            PG8_LDB(B1, 0, 1); PG8_STAGE(PG8_SB(0, 0), b2, voffB);
            PG8_BAR; PG8_WAIT_L(0); PG8_MMA(0, 1, At, B1); PG8_BAR;
            PG8_LDA(At, 0, 1); PG8_STAGE(PG8_SA(0, 0), a2, voffA);
            PG8_BAR; PG8_WAIT_L(0); PG8_MMA(1, 0, At, B0); PG8_BAR; PG8_SCHED;
            PG8_STAGE(PG8_SB(0, 1), b2 + hstep, voffB);
            PG8_WAIT_V(6); PG8_BAR; PG8_MMA(1, 1, At, B1); PG8_BAR;
            PG8_LDB(B0, 1, 0); PG8_SCHED; PG8_LDA(At, 1, 0); PG8_STAGE(PG8_SA(0, 1), a2 + hstep, voffA);
            PG8_WAIT_L(8); PG8_BAR; PG8_WAIT_L(0); PG8_MMA(0, 0, At, B0); PG8_BAR; PG8_SCHED;
            PG8_LDB(B1, 1, 1); PG8_STAGE(PG8_SB(1, 0), b3, voffB);
            PG8_BAR; PG8_WAIT_L(0); PG8_MMA(0, 1, At, B1); PG8_BAR;
            PG8_LDA(At, 1, 1); PG8_STAGE(PG8_SA(1, 0), a3, voffA);
            PG8_BAR; PG8_WAIT_L(0); PG8_MMA(1, 0, At, B0); PG8_BAR; PG8_SCHED;
            PG8_STAGE(PG8_SB(1, 1), b3 + hstep, voffB);
            PG8_WAIT_V(6); PG8_BAR; PG8_MMA(1, 1, At, B1); PG8_BAR;
#else
            PG8_LDB(B0, 0, 0); PG8_LDB(B1, 0, 1); PG8_SCHED; PG8_LDA(At, 0, 0); PG8_STAGE(PG8_SA(1, 1), a1 + hstep, voffA);
            PG8_WAIT_V(8);
            PG8_WAIT_L(0); PG8_BAR; PG8_MMA(0, 0, At, B0); PG8_MMA(0, 1, At, B1); PG8_BAR; PG8_SCHED;
            PG8_LDA(At, 0, 1); PG8_STAGE(PG8_SB(0, 0), b2, voffB); PG8_STAGE(PG8_SB(0, 1), b2 + hstep, voffB); PG8_STAGE(PG8_SA(0, 0), a2, voffA);
            PG8_WAIT_V(8);
            PG8_WAIT_L(0); PG8_BAR; PG8_MMA(1, 0, At, B0); PG8_MMA(1, 1, At, B1); PG8_BAR; PG8_SCHED;
            PG8_LDB(B0, 1, 0); PG8_LDB(B1, 1, 1); PG8_SCHED; PG8_LDA(At, 1, 0); PG8_STAGE(PG8_SA(0, 1), a2 + hstep, voffA);
            PG8_WAIT_V(8); PG8_WAIT_L(0); PG8_BAR; PG8_MMA(0, 0, At, B0); PG8_MMA(0, 1, At, B1); PG8_BAR; PG8_SCHED;
            PG8_LDA(At, 1, 1); PG8_STAGE(PG8_SB(1, 0), b3, voffB); PG8_STAGE(PG8_SB(1, 1), b3 + hstep, voffB); PG8_STAGE(PG8_SA(1, 0), a3, voffA);
            PG8_WAIT_V(8); PG8_WAIT_L(0); PG8_BAR; PG8_MMA(1, 0, At, B0); PG8_MMA(1, 1, At, B1); PG8_BAR; PG8_SCHED;
#endif
        }
#ifndef PG8_OLD
        if (wr == 0) PG8_BAR;
#endif
        if (cur.part >= 0) {
            float* pt = PART + (size_t)cur.part * 65536 + (size_t)(wr * 64 + fr) * 256 + wc * 32 + 8 * fq;
#pragma unroll
            for (int ai = 0; ai < 2; ++ai)
#pragma unroll
                for (int m = 0; m < 4; ++m)
#pragma unroll
                    for (int bj = 0; bj < 2; ++bj) { float* q = pt + (size_t)(ai * 128 + m * 16) * 256 + bj * 128; *(f32x4*)q = acc[ai][bj][m][0]; *(f32x4*)(q + 4) = acc[ai][bj][m][1]; }
        } else E(acc, cur, wr, wc, fr, fq);
        if (!has_next) break;
#pragma unroll
        for (int a = 0; a < 2; ++a)
#pragma unroll
            for (int b = 0; b < 2; ++b)
#pragma unroll
                for (int m = 0; m < 4; ++m)
#pragma unroll
                    for (int n = 0; n < 2; ++n) acc[a][b][m][n] = (f32x4){0.f, 0.f, 0.f, 0.f};
        cur = nxt; cA = nA; cB = nB; nt = cur.nt; ++ui;
#ifndef PG8_OLD
        if (wr == 1) PG8_BAR;
#endif
    }
    PG8_WAIT_V(0);
#ifdef PG8_OLD
    if (wr == 0) PG8_BAR;
#endif
    PG8_BAR;
#undef PG8_SA
#undef PG8_SB
#undef PG8_STAGE
#undef PG8_LDA
#undef PG8_LDB
#undef PG8_MMA
#undef PG8_WAIT_V
#undef PG8_WAIT_L
#undef PG8_BAR
#undef PG8_SCHED
}
}
using pg8::Unit;

typedef f32x4 Acc[2][2][4][2];
#define EPI_ROWS(...) _Pragma("unroll") for (int ai = 0; ai < 2; ++ai) _Pragma("unroll") for (int m = 0; m < 4; ++m) { const int row = u.pm * 256 + ai * 128 + wr * 64 + m * 16 + fr; __VA_ARGS__ }
__device__ __forceinline__ u32x4 pack8(const f32x4 a, const f32x4 b) { u32x4 w; w.x = cvt_pk_bf16(a[0], a[1]); w.y = cvt_pk_bf16(a[2], a[3]); w.z = cvt_pk_bf16(b[0], b[1]); w.w = cvt_pk_bf16(b[2], b[3]); return w; }

struct EpiRowScale {
    static constexpr int MINST = 16;
    const ssq_t* ss; bf16_t* O0; int ld0; int split; bf16_t* O1; int ld1; int nstate; int state_cols; float* st_p; float* st_s; bf16_t* halo;
    __device__ __forceinline__ void operator()(Acc& acc, const Unit& u, int wr, int wc, int fr, int fq) const {
        int colt = u.pn * 256; bf16_t* base = O0; int ld = ld0; const int gcol0 = colt + wc * 32 + 8 * fq; const bool halo_tile = halo != nullptr && colt < 4096;
        if (colt >= split) { base = O1; ld = ld1; colt -= split; }
        const int col0 = colt + wc * 32 + 8 * fq;
        const bool st_tile = nstate > 0 && (u.pn * 256 < state_cols);
        EPI_ROWS(
            const float rs = ss ? rstd_of(ss, row) : 1.0f;
            bf16_t* rowp = base + (size_t)row * ld + col0;
            _Pragma("unroll") for (int bj = 0; bj < 2; ++bj) *(u32x4*)(rowp + bj * 128) = pack8(acc[ai][bj][m][0] * rs, acc[ai][bj][m][1] * rs);
            if (halo_tile && (row & 63) >= 61) { bf16_t* hp = halo + ((size_t)(row >> 6) * 3 + ((row & 63) - 61)) * 4096 + gcol0;
                _Pragma("unroll") for (int bj = 0; bj < 2; ++bj) *(u32x4*)(hp + bj * 128) = pack8(acc[ai][bj][m][0] * rs, acc[ai][bj][m][1] * rs); }
            if (st_tile) { int b, s, S; row_pos(row, b, s, S); const int j = s - (S - nstate);
                if (j >= 0) { float* dst = (row < MP ? st_p : st_s) + ((size_t)b * nstate + j) * state_cols + gcol0;
                    _Pragma("unroll") for (int bj = 0; bj < 2; ++bj) { *(f32x4*)(dst + bj * 128) = acc[ai][bj][m][0] * rs; *(f32x4*)(dst + bj * 128 + 4) = acc[ai][bj][m][1] * rs; } } }
        )
    }
};
struct EpiA1 {
    static constexpr int MINST = 16;
    const ssq_t* ss; bf16_t* BG; bf16_t* CV; float* st_p; float* st_s;
    __device__ __forceinline__ void operator()(Acc& acc, const Unit& u, int wr, int wc, int fr, int fq) const {
        if (u.pn < 8) {
            const int col0 = u.pn * 256 + wc * 32 + 8 * fq;
            EPI_ROWS(
                const float rs = rstd_of(ss, row); bf16_t* rowp = BG + (size_t)row * DM + col0;
                _Pragma("unroll") for (int bj = 0; bj < 2; ++bj) *(u32x4*)(rowp + bj * 128) = pack8(acc[ai][bj][m][0] * rs, acc[ai][bj][m][1] * rs);
            )
        } else {
            const int ch0 = (u.pn - 8) * 128 + wc * 32 + 8 * fq;
            EPI_ROWS(
                const float rs = rstd_of(ss, row); const float rs2 = rs * rs;
                const f32x4 c0 = acc[ai][0][m][0] * acc[ai][1][m][0] * rs2, c1 = acc[ai][0][m][1] * acc[ai][1][m][1] * rs2;
                *(u32x4*)(CV + (size_t)row * DM + ch0) = pack8(c0, c1);
                int b, s, S; row_pos(row, b, s, S); const int j = s - (S - 2);
                if (j >= 0) { float* dst = (row < MP ? st_p : st_s) + ((size_t)b * 2 + j) * DM + ch0; *(f32x4*)dst = c0; *(f32x4*)(dst + 4) = c1; }
            )
        }
    }
};
#ifndef RES16
#define RES16 1
#endif
template <bool PLEGATE> struct EpiResid {
    static constexpr int MINST = 16;
    float* H; const bf16_t* HBI; bf16_t* HB; ssq_t* ssn; const ssq_t* ssc; const bf16_t* PPB;
    __device__ __forceinline__ void operator()(Acc& acc, const Unit& u, int wr, int wc, int fr, int fq) const {
        const int col0 = u.pn * 256 + wc * 32 + 8 * fq;
        EPI_ROWS(
            float rs = 1.0f; if (PLEGATE) rs = rstd_of(ssc, row);
            float sq = 0.f;
            _Pragma("unroll") for (int bj = 0; bj < 2; ++bj) {
                const size_t off = (size_t)row * DM + col0 + bj * 128;
                f32x4 h0; f32x4 h1;
                if (RES16) { const u32x4 hw = *(const u32x4*)(HBI + off); h0 = (f32x4){bflo(hw.x), bfhi(hw.x), bflo(hw.y), bfhi(hw.y)}; h1 = (f32x4){bflo(hw.z), bfhi(hw.z), bflo(hw.w), bfhi(hw.w)}; }
                else { h0 = *(const f32x4*)(H + off); h1 = *(const f32x4*)(H + off + 4); }
                f32x4 a0 = acc[ai][bj][m][0], a1 = acc[ai][bj][m][1];
                if (PLEGATE) {
                    const u32x4 pw = *(const u32x4*)(PPB + off);
                    const f32x4 p0 = (f32x4){bflo(pw.x), bfhi(pw.x), bflo(pw.y), bfhi(pw.y)}, p1 = (f32x4){bflo(pw.z), bfhi(pw.z), bflo(pw.w), bfhi(pw.w)};
                    _Pragma("unroll") for (int e = 0; e < 4; ++e) { a0[e] = p0[e] * sigmoidf_(a0[e] * rs); a1[e] = p1[e] * sigmoidf_(a1[e] * rs); }
                }
                h0 += a0; h1 += a1;
                if (!RES16) { *(f32x4*)(H + off) = h0; *(f32x4*)(H + off + 4) = h1; }
                *(u32x4*)(HB + off) = pack8(h0, h1);
                sq += (h0[0] * h0[0] + h0[1] * h0[1]) + (h0[2] * h0[2] + h0[3] * h0[3]) + (h1[0] * h1[0] + h1[1] * h1[1]) + (h1[2] * h1[2] + h1[3] * h1[3]);
            }
            sq += __shfl_xor(sq, 16); sq += __shfl_xor(sq, 32);
            if (fq == 0) atomicAdd(ssn + row, ssq_fix(sq));
        )
    }
};

#ifdef DPP_FLIP
#define DPP_R1 0x12F
#define DPP_R2 0x12E
#else
#define DPP_R1 0x121
#define DPP_R2 0x122
#endif
__device__ __forceinline__ float dpp_ror1(float v) { return __int_as_float(__builtin_amdgcn_update_dpp(0, __float_as_int(v), DPP_R1, 0xf, 0xf, false)); }
__device__ __forceinline__ float dpp_ror2(float v) { return __int_as_float(__builtin_amdgcn_update_dpp(0, __float_as_int(v), DPP_R2, 0xf, 0xf, false)); }
struct EpiGlu {
    static constexpr int MINST = 16;
    const ssq_t* ss; bf16_t* ACT; float* XB; const float* wc; const float* bc; float* st_p; float* st_s;
    __device__ __forceinline__ void operator()(Acc& acc, const Unit& u, int wr, int wc_, int fr, int fq) const {
        const int j0 = u.pn * 128 + wc_ * 32 + 8 * fq;
#pragma unroll
        for (int ai = 0; ai < 2; ++ai)
#pragma unroll
            for (int m = 0; m < 4; ++m) { const float rs = rstd_of(ss, u.pm * 256 + ai * 128 + wr * 64 + m * 16 + fr);
#pragma unroll
                for (int bj = 0; bj < 2; ++bj) { acc[ai][bj][m][0] *= rs; acc[ai][bj][m][1] *= rs; } }
#pragma unroll
        for (int n = 0; n < 2; ++n) {
            const int jc = j0 + 4 * n;
            f32x4 wg[3], wu[3];
#pragma unroll
            for (int d = 0; d < 3; ++d) { wg[d] = *(const f32x4*)(wc + d * DFF2 + jc); wu[d] = *(const f32x4*)(wc + d * DFF2 + DFF + jc); }
            const f32x4 bg = *(const f32x4*)(bc + jc), bu = *(const f32x4*)(bc + DFF + jc);
#pragma unroll
            for (int ai = 0; ai < 2; ++ai) {
#pragma unroll
                for (int m = 0; m < 4; ++m) {
                    const int row = u.pm * 256 + ai * 128 + wr * 64 + m * 16 + fr, r64 = m * 16 + fr;
                    const f32x4 cg = acc[ai][0][m][n], cu = acc[ai][1][m][n];
                    const f32x4 pg = acc[ai][0][m > 0 ? m - 1 : 0][n], pu = acc[ai][1][m > 0 ? m - 1 : 0][n];
                    f32x4 g1, g2, u1, u2;
#pragma unroll
                    for (int e = 0; e < 4; ++e) {
                        g1[e] = DPPF(dpp_ror1(pg[e]), cg[e], 0x111, 0xf); g2[e] = DPPF(dpp_ror2(pg[e]), cg[e], 0x112, 0xf);
                        u1[e] = DPPF(dpp_ror1(pu[e]), cu[e], 0x111, 0xf); u2[e] = DPPF(dpp_ror2(pu[e]), cu[e], 0x112, 0xf);
                    }
                    const f32x4 ug = wg[0] * g2 + wg[1] * g1 + wg[2] * cg + bg, uu = wu[0] * u2 + wu[1] * u1 + wu[2] * cu + bu;
                    f32x4 o;
#pragma unroll
                    for (int e = 0; e < 4; ++e) o[e] = siluf_(ug[e]) * uu[e];
                    if (r64 >= 2) { u32x2 w; w.x = cvt_pk_bf16(o[0], o[1]); w.y = cvt_pk_bf16(o[2], o[3]); *(u32x2*)(ACT + (size_t)row * DFF + jc) = w; }
                    if (r64 < 2 || r64 >= 62) {
                        float* xb = XB + ((size_t)(row >> 6) * 4 + ((r64 + 2) & 3)) * DFF2 + jc;
                        *(f32x4*)xb = cg; *(f32x4*)(xb + DFF) = cu;
                        if (r64 >= 62) { int b, s, S; row_pos(row, b, s, S);
                            if (s >= S - 2) { float* dst = (row < MP ? st_p : st_s) + ((size_t)b * 2 + (s - (S - 2))) * DFF2 + jc; *(f32x4*)dst = cg; *(f32x4*)(dst + DFF) = cu; } }
                    }
                }
            }
        }
    }
};
struct EpiNull { static constexpr int MINST = 0; __device__ __forceinline__ void operator()(Acc& acc, const Unit& u, int wr, int wc, int fr, int fq) const { asm volatile("" :: "v"(acc[0][0][0][0][0])); } };
struct EpiPlain {
    static constexpr int MINST = 16;
    bf16_t* O; int ld;
    __device__ __forceinline__ void operator()(Acc& acc, const Unit& u, int wr, int wc, int fr, int fq) const {
        const int col0 = u.pn * 256 + wc * 32 + 8 * fq;
        EPI_ROWS(
            bf16_t* rowp = O + (size_t)row * ld + col0;
            _Pragma("unroll") for (int bj = 0; bj < 2; ++bj) *(u32x4*)(rowp + bj * 128) = pack8(acc[ai][bj][m][0], acc[ai][bj][m][1]);
        )
    }
};
__device__ __forceinline__ int src_col(int cmap, int col_off, int n) {
    if (cmap == 1) { if (n < 2048) return n; const int t = (n - 2048) >> 8, w = (n - 2048) & 255; return w < 128 ? 2048 + 128 * t + w : 4096 + 128 * t + (w - 128); }
    if (cmap == 2) { const int t = n >> 8, w = n & 255; return w < 128 ? 128 * t + w : DFF + 128 * t + (w - 128); }
    return col_off + n;
}
__device__ __forceinline__ void prep_matrix(int wv, LAS float* tile, const float* W, int ldw, int K, int nrows, bf16_t* dst, const float* gain, int cmap, int col_off, int& tctr, const int G, const int c, const int row0 = 0) {
    const int tid = fresh_tid(wv);
    if (nrows >= 128) {
        const int ktiles = K >> 7, ntiles = nrows >> 7, total = ktiles * ntiles;
        int t = (int)((c + G - (tctr % G)) % G);
        const int lane = tid & 63, wid = tid >> 6, ks = (wid >> 2) * 64 + 8 * (lane >> 3), ns = (wid & 3) * 32 + 4 * (lane & 7);
        const __amdgpu_buffer_rsrc_t drs = __builtin_amdgcn_make_buffer_rsrc((void*)dst, 0, 0x7fffffff, 0x00020000);
        f32x4 v[8];
#define PREP_LOAD(tt) do { const int nt_ = (tt) / ktiles, kt_ = (tt) % ktiles; const float* src_ = W + (size_t)(kt_ * 128 + ks) * ldw + src_col(cmap, col_off, row0 + nt_ * 128) + ns; \
            _Pragma("unroll") for (int p = 0; p < 8; ++p) v[p] = __builtin_nontemporal_load((const f32x4*)(src_ + (size_t)p * ldw)); } while (0)
        if (t < total) PREP_LOAD(t);
        for (; t < total; t += G) {
            const int nt = t / ktiles, kt = t % ktiles, n0 = nt * 128, k0 = kt * 128;
            f32x4 g0 = {1.f, 1.f, 1.f, 1.f}, g1 = g0; if (gain) { g0 = *(const f32x4*)(gain + k0 + ks); g1 = *(const f32x4*)(gain + k0 + ks + 4); }
            u32x4 w[4];
#pragma unroll
            for (int e = 0; e < 4; ++e) { w[e].x = cvt_pk_bf16(v[0][e] * g0[0], v[1][e] * g0[1]); w[e].y = cvt_pk_bf16(v[2][e] * g0[2], v[3][e] * g0[3]);
                w[e].z = cvt_pk_bf16(v[4][e] * g1[0], v[5][e] * g1[1]); w[e].w = cvt_pk_bf16(v[6][e] * g1[2], v[7][e] * g1[3]); }
            if (t + G < total) PREP_LOAD(t + G);
            const unsigned d_ = (unsigned)(((size_t)(row0 + n0 + ns) * K + k0 + ks) * 2);
#pragma unroll
            for (int e = 0; e < 4; ++e) __builtin_amdgcn_raw_buffer_store_b128(w[e], drs, (int)(d_ + (unsigned)e * (unsigned)K * 2u), 0, WT_AUX);
        }
#undef PREP_LOAD
        tctr += total;
    } else {
        const int ktiles = K >> 6, ntiles = nrows >> 6, total = ktiles * ntiles;
        int t = (int)((c + G - (tctr % G)) % G);
        for (; t < total; t += G) {
            const int nt = t / ktiles, kt = t % ktiles, n0 = nt * 64, k0 = kt * 64, ns0 = src_col(cmap, col_off, n0);
            const int ty = tid >> 4, tx = tid & 15;
#pragma unroll
            for (int p = 0; p < 2; ++p) { const int k = k0 + ty + 32 * p; const f32x4 v = *(const f32x4*)(W + (size_t)k * ldw + ns0 + 4 * tx); const float g = gain ? gain[k] : 1.0f;
#pragma unroll
                for (int e = 0; e < 4; ++e) tile[(4 * tx + e) * 129 + ty + 32 * p] = v[e] * g; }
            __syncthreads();
            { const int n = tid >> 3, kg = tid & 7; const LAS float* src = tile + n * 129 + 8 * kg;
              u32x4 w; w.x = cvt_pk_bf16(src[0], src[1]); w.y = cvt_pk_bf16(src[2], src[3]); w.z = cvt_pk_bf16(src[4], src[5]); w.w = cvt_pk_bf16(src[6], src[7]);
              *(u32x4*)(dst + (size_t)(n0 + n) * K + k0 + 8 * kg) = w; }
            __syncthreads();
        }
        tctr += total;
    }
}
#ifndef JOBSITES
#define JOBSITES 0, 1, 6, 6, 0, 0, 3, 0, 5,  1, 1, 1, 1, 1, 1, 0,  2, 2, 2, 3, 4, 4, 0,  5, 5, 5, 5, 5, 5, 0,  7, 7, 7, 7, 8, 7, 0
#endif
constexpr int job_site(int j) { constexpr int t[37] = {JOBSITES}; return t[j]; }
#ifndef JOBSITES2
#define JOBSITES2 0
#endif
constexpr bool job_in(int j, int site) { constexpr int t2[37] = {JOBSITES2}; return site == 99 ? t2[j] == 1 : job_site(j) == site; }
template <int SITE>
__device__ __forceinline__ void prep_jobs(const Params& P, int wv, LAS unsigned char* lds, const int G, const int c) {
    unsigned char* ws = P.ws; asm volatile("" : "+s"(ws)); LAS float* tile = (LAS float*)lds; int tctr = 0;
#define JOB(j, ...) if (job_in(j, SITE)) prep_matrix(wv, tile, __VA_ARGS__, tctr, G, c);
    JOB(0, P.in[I_WAIN], 6144, 2048, 6144, (bf16_t*)(ws + WS_WAIN), P.in[I_GMIX], 1, 0)
    JOB(1, P.in[I_WAOUT], 2048, 2048, 2048, (bf16_t*)(ws + WS_WAOUT), nullptr, 0, 0)
    JOB(2, P.in[I_WAIN] + (size_t)2048 * 6144, 6144, 2048, 6144, (bf16_t*)(ws + WS_WAIN) + (size_t)6144 * 2048, P.in[I_GMIX] + 3 * 2048, 1, 0)
    JOB(3, P.in[I_WAOUT] + (size_t)2048 * 2048, 2048, 2048, 2048, (bf16_t*)(ws + WS_WAOUT) + (size_t)2048 * 2048, nullptr, 0, 0)
    JOB(4, P.in[I_WBIN], DNIN, 2048, 12288, (bf16_t*)(ws + WS_WBIN), P.in[I_GMIX] + 1 * 2048, 0, 0)
    JOB(5, P.in[I_WBIN], DNIN, 2048, 64, (bf16_t*)(ws + WS_WBBA), P.in[I_GMIX] + 1 * 2048, 0, 12288)
    JOB(6, P.in[I_WBOUT], 2048, 4096, 2048, (bf16_t*)(ws + WS_WBOUT), nullptr, 0, 0)
    JOB(7, P.in[I_WCQKV], 6144, 2048, 6144, (bf16_t*)(ws + WS_WCQKV), P.in[I_GMIX] + 2 * 2048, 0, 0)
    JOB(8, P.in[I_WCOUT], 2048, 2048, 2048, (bf16_t*)(ws + WS_WCOUT), nullptr, 0, 0)
#define JOB_FUP(i, q) if (job_in(9 + 7 * i + q, SITE)) prep_matrix(wv, tile, P.in[I_WFUP] + (size_t)i * 2048 * DFF2, DFF2, 2048, DFF2 / 4, (bf16_t*)(ws + WS_WFUP) + (size_t)i * DFF2 * 2048, P.in[I_GFFN] + i * 2048, 2, 0, tctr, G, c, q * (DFF2 / 4));
#define JOBS_FFN(i) JOB_FUP(i, 0) JOB_FUP(i, 1) JOB_FUP(i, 2) JOB_FUP(i, 3) \
    JOB(13 + 7 * i, P.in[I_WFDOWN] + (size_t)i * DFF * 2048, 2048, DFF, 2048, (bf16_t*)(ws + WS_WFDOWN) + (size_t)i * 2048 * DFF, nullptr, 0, 0) \
    JOB(14 + 7 * i, P.in[I_WPG] + (size_t)i * 2048 * 2048, 2048, 2048, 2048, (bf16_t*)(ws + WS_WPG) + (size_t)i * 2048 * 2048, P.in[I_GPLE] + i * 2048, 0, 0) \
    JOB(15 + 7 * i, P.in[I_WPP] + (size_t)i * PLE * 2048, 2048, PLE, 2048, (bf16_t*)(ws + WS_WPP) + (size_t)i * 2048 * PLE, nullptr, 0, 0)
    JOBS_FFN(0) JOBS_FFN(1) JOBS_FFN(2) JOBS_FFN(3)
#undef JOBS_FFN
#undef JOB_FUP
#undef JOB
}
template <int SITE>
__device__ __forceinline__ void prep_fill(const Params& P, int wv, LAS unsigned char* lds, int nunits, int G, int wg) {
    const int rem = nunits % G, G2 = rem ? G - rem : G, c2 = rem ? wg - rem : wg;
    if (c2 >= 0) prep_jobs<SITE>(P, wv, lds, G2, c2);
}
__device__ __forceinline__ void phase_prologue(const Params& P, int wv, LAS unsigned char* lds) {
    unsigned char* ws = P.ws;
    prep_jobs<0>(P, wv, lds, (int)gridDim.x, (int)blockIdx.x);
    const int tid_ = fresh_tid(wv), lane = tid_ & 63, gw = blockIdx.x * 8 + (tid_ >> 6), nw = gridDim.x * 8;
    float* H = (float*)(ws + WS_H); bf16_t* HB = (bf16_t*)(ws + WS_HB); ssq_t* SS0 = (ssq_t*)(ws + WS_SS);
    for (int row = gw; row < MT; row += nw) {
        const float* src = row < MP ? P.in[I_XP] + (size_t)row * DM : P.in[I_XS] + (size_t)(row - MP) * DM;
        float sq = 0.f;
#pragma unroll
        for (int j = 0; j < 4; ++j) {
            const int c = (j * 64 + lane) * 8;
            const f32x4 a = *(const f32x4*)(src + c), b = *(const f32x4*)(src + c + 4);
            if (!RES16) { *(f32x4*)(H + (size_t)row * DM + c) = a; *(f32x4*)(H + (size_t)row * DM + c + 4) = b; }
            *(u32x4*)(HB + (size_t)row * DM + c) = pack8(a, b);
            sq += (a[0] * a[0] + a[1] * a[1]) + (a[2] * a[2] + a[3] * a[3]) + (b[0] * b[0] + b[1] * b[1]) + (b[2] * b[2] + b[3] * b[3]);
        }
        sq = wave_sum(sq);
        if (lane == 0) SS0[row] = ssq_fix(sq);
    }
    { ssq_t* SSz = (ssq_t*)(ws + WS_SS) + MT; const size_t nz = (size_t)(NSS - 1) * MT;
      for (size_t i = (size_t)blockIdx.x * NTH + fresh_tid(wv); i < nz; i += (size_t)gridDim.x * NTH) SSz[i] = 0ull; }
    bf16_t* PB = (bf16_t*)(ws + WS_PB);
    const size_t n8 = (size_t)4 * MT * PLE / 8;
    const size_t pstep = (size_t)gridDim.x * NTH;
    for (size_t i0 = (size_t)blockIdx.x * NTH + fresh_tid(wv); i0 < n8; i0 += 4 * pstep) {
        f32x4 pa[4], pb[4];
#pragma unroll
        for (int u = 0; u < 4; ++u) { const size_t i = i0 + u * pstep; pa[u] = (f32x4){0.f, 0.f, 0.f, 0.f}; pb[u] = pa[u];
            if (i < n8) { const size_t e = i * 8; const int L = (int)(e / ((size_t)MT * PLE)); const size_t r = e % ((size_t)MT * PLE); const int row = (int)(r / PLE), c = (int)(r % PLE);
                const float* src = row < MP ? P.in[I_PP] + ((size_t)L * MP + row) * PLE + c : P.in[I_PS] + ((size_t)L * MS + (row - MP)) * PLE + c;
                pa[u] = *(const f32x4*)src; pb[u] = *(const f32x4*)(src + 4); } }
#pragma unroll
        for (int u = 0; u < 4; ++u) { const size_t i = i0 + u * pstep; if (i < n8) *(u32x4*)(PB + i * 8) = pack8(pa[u], pb[u]); }
    }
}

__device__ __forceinline__ void ld8(const bf16_t* p, float (&x)[8]) { const u32x4 w = *(const u32x4*)p; x[0] = bflo(w.x); x[1] = bfhi(w.x); x[2] = bflo(w.y); x[3] = bfhi(w.y); x[4] = bflo(w.z); x[5] = bfhi(w.z); x[6] = bflo(w.w); x[7] = bfhi(w.w); }
__device__ __forceinline__ void phase_ea(const Params& P, int wv, int j  ) {
    unsigned char* ws = P.ws; const bf16_t* BG = (const bf16_t*)(ws + AR_BG); const bf16_t* CV = (const bf16_t*)(ws + AR_CV); bf16_t* AA = (bf16_t*)(ws + AR_AA);
    const float* wc = P.in[I_WACONV] + (size_t)j * 3 * DM; const float* hist = P.in[I_STA] + (size_t)j * NBS * 2 * DM;
    const int gt = blockIdx.x * NTH + fresh_tid(wv), nthr = gridDim.x * NTH, c = (gt & 255) * 8, walker = gt >> 8, nwalk = nthr >> 8;
    const int per = (MT + nwalk - 1) / nwalk, r0 = walker * per, r1 = (r0 + per) < MT ? (r0 + per) : MT;
    float w0[8], w1[8], w2[8];
#pragma unroll
    for (int e = 0; e < 8; ++e) { w0[e] = wc[c + e]; w1[e] = wc[DM + c + e]; w2[e] = wc[2 * DM + c + e]; }
    float x1[8], x2[8];
#pragma unroll
    for (int e = 0; e < 8; ++e) { x1[e] = 0.f; x2[e] = 0.f; }
    if (r0 < r1) { int b, s, S; row_pos(r0, b, s, S); if (s >= 1) ld8(CV + (size_t)(r0 - 1) * DM + c, x1); if (s >= 2) ld8(CV + (size_t)(r0 - 2) * DM + c, x2); }
    constexpr int U = 4;
    for (int rowb = r0; rowb < r1; rowb += U) {
        u32x4 xr[U], gr[U];
#pragma unroll
        for (int u = 0; u < U; ++u) { xr[u] = (u32x4){0u, 0u, 0u, 0u}; gr[u] = xr[u]; if (rowb + u < r1) { xr[u] = *(const u32x4*)(CV + (size_t)(rowb + u) * DM + c); gr[u] = *(const u32x4*)(BG + (size_t)(rowb + u) * DM + c); } }
#pragma unroll
        for (int u = 0; u < U; ++u) { const int row = rowb + u;
            if (row < r1) {
                int b, s, S; row_pos(row, b, s, S);
                float x0[8], g[8];
                x0[0] = bflo(xr[u].x); x0[1] = bfhi(xr[u].x); x0[2] = bflo(xr[u].y); x0[3] = bfhi(xr[u].y); x0[4] = bflo(xr[u].z); x0[5] = bfhi(xr[u].z); x0[6] = bflo(xr[u].w); x0[7] = bfhi(xr[u].w);
                g[0] = bflo(gr[u].x); g[1] = bfhi(gr[u].x); g[2] = bflo(gr[u].y); g[3] = bfhi(gr[u].y); g[4] = bflo(gr[u].z); g[5] = bfhi(gr[u].z); g[6] = bflo(gr[u].w); g[7] = bfhi(gr[u].w);
                if (s < 2) {
                    if (row >= MP) { const float* h1 = hist + ((size_t)b * 2 + 1) * DM + c; const float* h0 = hist + ((size_t)b * 2) * DM + c;
#pragma unroll
                        for (int e = 0; e < 8; ++e) { if (s == 0) { x1[e] = h1[e]; x2[e] = h0[e]; } else x2[e] = h1[e]; } }
                    else {
#pragma unroll
                        for (int e = 0; e < 8; ++e) { if (s == 0) { x1[e] = 0.f; x2[e] = 0.f; } else x2[e] = 0.f; } }
                }
                float o[8];
#pragma unroll
                for (int e = 0; e < 8; ++e) { o[e] = g[e] * (w0[e] * x2[e] + w1[e] * x1[e] + w2[e] * x0[e]); x2[e] = x1[e]; x1[e] = x0[e]; }
                u32x4 w; w.x = cvt_pk_bf16(o[0], o[1]); w.y = cvt_pk_bf16(o[2], o[3]); w.z = cvt_pk_bf16(o[4], o[5]); w.w = cvt_pk_bf16(o[6], o[7]);
                *(u32x4*)(AA + (size_t)row * DM + c) = w;
            } }
    }
}

__device__ __forceinline__ void phase_ef(const Params& P, int wv, int L) {
    unsigned char* ws = P.ws; const float* XB = (const float*)(ws + AR_XB); bf16_t* ACT = (bf16_t*)(ws + AR_ACT);
    const float* wc = P.in[I_WFCONV] + (size_t)L * 3 * DFF2; const float* bc = P.in[I_BFCONV] + (size_t)L * DFF2; const float* hist = P.in[I_STF] + (size_t)L * NBS * 2 * DFF2;
    const int per_row = DFF / 4, total = (MT / 64) * 2 * per_row;
    constexpr int U = 2;
    const int step = gridDim.x * NTH;
    for (int i0 = blockIdx.x * NTH + fresh_tid(wv); i0 < total; i0 += U * step) {
        f32x4 x[U][2][3], wt[U][2][4];
#pragma unroll
        for (int u = 0; u < U; ++u) { const int i = i0 + u * step;
#pragma unroll
            for (int h = 0; h < 2; ++h) {
#pragma unroll
                for (int d = 0; d < 3; ++d) x[u][h][d] = (f32x4){0.f, 0.f, 0.f, 0.f};
#pragma unroll
                for (int d = 0; d < 4; ++d) wt[u][h][d] = (f32x4){0.f, 0.f, 0.f, 0.f}; }
            if (i < total) {
                const int blk = i / (2 * per_row), r = (i / per_row) & 1, c = (i % per_row) * 4, row = blk * 64 + r; int b, s, S; row_pos(row, b, s, S);
#pragma unroll
                for (int h = 0; h < 2; ++h) {
                    const int cc = c + h * DFF;
                    x[u][h][2] = *(const f32x4*)(XB + ((size_t)blk * 4 + 2 + r) * DFF2 + cc);
#pragma unroll
                    for (int d = 1; d <= 2; ++d) {
                        const int p = r - d;
                        if (p >= 0) x[u][h][2 - d] = *(const f32x4*)(XB + ((size_t)blk * 4 + 2 + p) * DFF2 + cc);
                        else if (s - d >= 0) x[u][h][2 - d] = *(const f32x4*)(XB + ((size_t)(blk - 1) * 4 + (2 + p)) * DFF2 + cc);
                        else if (row >= MP) x[u][h][2 - d] = *(const f32x4*)(hist + ((size_t)b * 2 + (2 + (s - d))) * DFF2 + cc);
                    }
                    wt[u][h][0] = *(const f32x4*)(wc + cc); wt[u][h][1] = *(const f32x4*)(wc + DFF2 + cc); wt[u][h][2] = *(const f32x4*)(wc + 2 * DFF2 + cc); wt[u][h][3] = *(const f32x4*)(bc + cc);
                }
            } }
#pragma unroll
        for (int u = 0; u < U; ++u) { const int i = i0 + u * step;
            if (i < total) {
                const int blk = i / (2 * per_row), r = (i / per_row) & 1, c = (i % per_row) * 4, row = blk * 64 + r;
                const f32x4 yg = wt[u][0][0] * x[u][0][0] + wt[u][0][1] * x[u][0][1] + wt[u][0][2] * x[u][0][2] + wt[u][0][3];
                const f32x4 yu = wt[u][1][0] * x[u][1][0] + wt[u][1][1] * x[u][1][1] + wt[u][1][2] * x[u][1][2] + wt[u][1][3];
                f32x4 o;
#pragma unroll
                for (int e2 = 0; e2 < 4; ++e2) o[e2] = siluf_(yg[e2]) * yu[e2];
                u32x2 w; w.x = cvt_pk_bf16(o[0], o[1]); w.y = cvt_pk_bf16(o[2], o[3]);
                *(u32x2*)(ACT + (size_t)row * DFF + c) = w;
            } }
    }
}


__device__ __forceinline__ void phase_reduce(const Params& P, int wv, int K, const float* PART, ssq_t* ssn, const ssq_t* ssc  , const bf16_t* HBI, bf16_t* HB) {
    unsigned char* ws = P.ws; float* H = (float*)(ws + WS_H); const bf16_t* PPB = (const bf16_t*)(ws + AR_PPB);
    pg8::StaticOrder S; S.init(MT, DM, K, (int)gridDim.x, 0, true);
    if (S.nreg == S.nwg) return;
    const int nleft = S.nwg - S.nreg;
    const int tid_ = fresh_tid(wv), lane = tid_ & 63, gw = blockIdx.x * 8 + (tid_ >> 6), nw = gridDim.x * 8;
    constexpr int U = 4;
    for (int tr0 = gw; tr0 < nleft * 256; tr0 += nw * U) {
        f32x4 pv[U][8]; u32x2 hw[U], pw[U]; ssq_t sr[U]; size_t offs[U]; int rows[U];
#pragma unroll
        for (int u = 0; u < U; ++u) { const int tr = tr0 + u * nw; pw[u] = (u32x2){0u, 0u}; sr[u] = 0ull; hw[u] = (u32x2){0u, 0u}; offs[u] = 0; rows[u] = 0;
            if (tr < nleft * 256) {
                const int j = tr >> 8, r = tr & 255, pq = S.map(S.nreg + j);
                rows[u] = (pq >> 16) * 256 + r; offs[u] = (size_t)rows[u] * DM + (pq & 0xffff) * 256 + 4 * lane;
#pragma unroll
                for (int k = 0; k < 8; ++k) pv[u][k] = *(const f32x4*)(PART + (size_t)(j * 8 + k) * 65536 + (size_t)r * 256 + 4 * lane);
                hw[u] = *(const u32x2*)(HBI + offs[u]);
                if (ssc) { sr[u] = ssc[rows[u]]; pw[u] = *(const u32x2*)(PPB + offs[u]); }
            } }
#pragma unroll
        for (int u = 0; u < U; ++u) { const int tr = tr0 + u * nw;
            if (tr < nleft * 256) {
                f32x4 s = (f32x4){0.f, 0.f, 0.f, 0.f};
#pragma unroll
                for (int k = 0; k < 8; ++k) s += pv[u][k];
                f32x4 h = (f32x4){bflo(hw[u].x), bfhi(hw[u].x), bflo(hw[u].y), bfhi(hw[u].y)};
                if (ssc) { const float rs = rsqrtf((float)sr[u] * (1.0f / (2048.0f * SSQ_SCALE)) + EPS);
                    h[0] += bflo(pw[u].x) * sigmoidf_(s[0] * rs); h[1] += bfhi(pw[u].x) * sigmoidf_(s[1] * rs); h[2] += bflo(pw[u].y) * sigmoidf_(s[2] * rs); h[3] += bfhi(pw[u].y) * sigmoidf_(s[3] * rs); }
                else h += s;
                u32x2 w; w.x = cvt_pk_bf16(h[0], h[1]); w.y = cvt_pk_bf16(h[2], h[3]); *(u32x2*)(HB + offs[u]) = w;
                float sq = (h[0] * h[0] + h[1] * h[1]) + (h[2] * h[2] + h[3] * h[3]); sq = wave_sum(sq);
                if (lane == 0) atomicAdd(ssn + rows[u], ssq_fix(sq));
            } }
    }
}

__device__ __forceinline__ void phase_final(const Params& P, int wv, const bf16_t* HB) {
    unsigned char* ws = P.ws; const float* H = (const float*)(ws + WS_H); const ssq_t* ss = (const ssq_t*)(ws + WS_SS) + (size_t)12 * MT; const float* g = P.in[I_GFIN];
    const int tid_ = fresh_tid(wv), lane = tid_ & 63, gw = blockIdx.x * 8 + (tid_ >> 6), nw = gridDim.x * 8;
    for (int rowb = gw; rowb < MT; rowb += 2 * nw) {
        u32x2 hw[2][8]; float rs[2];
#pragma unroll
        for (int u = 0; u < 2; ++u) { const int row = rowb + u * nw; rs[u] = 0.f;
#pragma unroll
            for (int j = 0; j < 8; ++j) hw[u][j] = (u32x2){0u, 0u};
            if (row < MT) { rs[u] = rstd_of(ss, row);
#pragma unroll
                for (int j = 0; j < 8; ++j) hw[u][j] = *(const u32x2*)(HB + (size_t)row * DM + (j * 64 + lane) * 4); } }
#pragma unroll
        for (int u = 0; u < 2; ++u) { const int row = rowb + u * nw;
            if (row < MT) {
                float* dst = row < MP ? P.out + O_YP + (size_t)row * DM : P.out + O_YS + (size_t)(row - MP) * DM;
#pragma unroll
                for (int j = 0; j < 8; ++j) { const int c = (j * 64 + lane) * 4; const u32x2 w = hw[u][j];
                    const f32x4 a = (f32x4){bflo(w.x), bfhi(w.x), bflo(w.y), bfhi(w.y)};
                    *(f32x4*)(dst + c) = a * rs[u] * *(const f32x4*)(g + c); }
            } }
    }
}

__device__ __forceinline__ void phase_ba(const Params& P, int wv, const ssq_t* ss, const bf16_t* HB) {
    unsigned char* ws = P.ws; const bf16_t* WBA = (const bf16_t*)(ws + WS_WBBA); float* BA = (float*)(ws + WS_BA);
    const int tid_ = fresh_tid(wv), lane = tid_ & 63, fr = lane & 15, fq = lane >> 4, gw = (tid_ >> 6) * gridDim.x + blockIdx.x, nw = gridDim.x * 8;
    for (int rt = gw; rt < MT / 16; rt += nw) {
        f32x4 acc[4];
#pragma unroll
        for (int n = 0; n < 4; ++n) acc[n] = (f32x4){0.f, 0.f, 0.f, 0.f};
        const bf16_t* ap = HB + (size_t)(rt * 16 + fr) * DM + 8 * fq;
#pragma unroll 8
        for (int k0 = 0; k0 < DM; k0 += 32) {
            const bf16x8 a = *(const bf16x8*)(ap + k0);
#pragma unroll
            for (int n = 0; n < 4; ++n) { const bf16x8 b = *(const bf16x8*)(WBA + (size_t)(n * 16 + fr) * DM + k0 + 8 * fq); acc[n] = __builtin_amdgcn_mfma_f32_16x16x32_bf16(b, a, acc[n], 0, 0, 0); }
        }
        const int row = rt * 16 + fr; const float rs = rstd_of(ss, row);
#pragma unroll
        for (int n = 0; n < 4; ++n) { f32x4 v = acc[n] * rs;
#pragma unroll
            for (int r = 0; r < 4; ++r) { if (n < 2) v[r] = sigmoidf_(v[r]); else { const int hv = (n - 2) * 16 + 4 * fq + r; const float aa = v[r] + P.in[I_DTB][hv]; v[r] = -__expf(P.in[I_ALOG][hv]) * (aa > 20.f ? aa : log1pf(__expf(aa))); } }
            *(f32x4*)(BA + (size_t)row * 64 + n * 16 + 4 * fq) = v; }
    }
}
__device__ __forceinline__ void phase_ec(const Params& P, int wv, LAS unsigned char* lds) {
    unsigned char* ws = P.ws; bf16_t* QKV = (bf16_t*)(ws + AR_QKV); bf16_t* VTP = (bf16_t*)(ws + AR_VTP); bf16_t* VTS = (bf16_t*)(ws + AR_VTS); bf16_t* KS = (bf16_t*)(ws + AR_KS);
    const float* gq = P.in[I_GCQ]; const float* gk = P.in[I_GCK];
    LAS bf16_t* tv = (LAS bf16_t*)lds;
    const int tid = fresh_tid(wv), lane = tid & 63, wid = tid >> 6;
    const int n_main = (MT / 64) * 16, n_hist = NBS * 16 * 8;
    const float* ck = P.in[I_CK]; const float* cv = P.in[I_CV];
    unsigned cur[32], nxt[32];
#define EC_ISSUE(BUF, it_) do { const int item_ = (it_); \
        if (item_ < n_main) { const int chunk_ = item_ >> 4, h_ = item_ & 15; \
            _Pragma("unroll") for (int i = 0; i < 8; ++i) { const unsigned* qp_ = (const unsigned*)(QKV + (size_t)(chunk_ * 64 + wid * 8 + i) * 6144 + h_ * 128) + lane; BUF[i] = qp_[0]; BUF[8 + i] = qp_[1024]; BUF[16 + i] = qp_[2048]; BUF[24 + i] = 0u; } } \
        else { const int it2_ = item_ - n_main, b_ = it2_ >> 7, h_ = (it2_ >> 3) & 15, jc_ = it2_ & 7; \
            _Pragma("unroll") for (int i = 0; i < 8; ++i) { const size_t o_ = (((size_t)b_ * 512 + jc_ * 64 + wid * 8 + i) * 16 + h_) * 128 + 2 * lane; const f32x2 kk_ = *(const f32x2*)(ck + o_), vv_ = *(const f32x2*)(cv + o_); \
                BUF[i] = __float_as_uint(kk_.x); BUF[8 + i] = __float_as_uint(kk_.y); BUF[16 + i] = __float_as_uint(vv_.x); BUF[24 + i] = __float_as_uint(vv_.y); } } } while (0)
    const int n_items = n_main + n_hist, G = (int)gridDim.x;
    int item = blockIdx.x;
#pragma unroll
    for (int i = 0; i < 32; ++i) { cur[i] = 0u; nxt[i] = 0u; }
    if (item < n_items) EC_ISSUE(cur, item);
    for (; item < n_items; item += G) {
        bf16_t* vt_dst; int vt_ld;
        if (item < n_main) {
            const int chunk = item >> 4, h = item & 15, row0 = chunk * 64;
            const float gq0 = gq[2 * lane], gq1 = gq[2 * lane + 1], gk0 = gk[2 * lane], gk1 = gk[2 * lane + 1];
#pragma unroll
            for (int i = 0; i < 8; ++i) {
                const int t = wid * 8 + i, row = row0 + t; int b, s, S; row_pos(row, b, s, S);
                unsigned* qp = (unsigned*)(QKV + (size_t)row * 6144 + h * 128) + lane; unsigned* kp = qp + 1024;
                const unsigned qw = cur[i], kw = cur[8 + i], vw = cur[16 + i];
                float q0 = bflo(qw), q1 = bfhi(qw), k0 = bflo(kw), k1 = bfhi(kw);
                const float qs = wave_sum(q0 * q0 + q1 * q1), ks = wave_sum(k0 * k0 + k1 * k1);
                const float rq = rsqrtf(qs * (1.0f / 128.0f) + EPS) * 0.08838834764831845f, rk = rsqrtf(ks * (1.0f / 128.0f) + EPS);
                q0 *= rq * gq0; q1 *= rq * gq1; k0 *= rk * gk0; k1 *= rk * gk1;
                *qp = cvt_pk_bf16(q0, q1); const unsigned kn = cvt_pk_bf16(k0, k1); *kp = kn;
                *(LAS unsigned*)(tv + t * 130 + 2 * lane) = vw;
                if (row < MP) { if (s >= SEQ - 512) { const size_t o = (((size_t)b * 512 + (s - (SEQ - 512))) * 16 + h) * 128 + 2 * lane;
                        *(f32x2*)(P.out + O_PCK + o) = (f32x2){k0, k1}; *(f32x2*)(P.out + O_PCV + o) = (f32x2){bflo(vw), bfhi(vw)}; } }
                else { const size_t o = (((size_t)b * 64 + s) * 16 + h) * 128 + 2 * lane;
                    *(f32x2*)(P.out + O_SCK + o) = (f32x2){k0, k1}; *(f32x2*)(P.out + O_SCV + o) = (f32x2){bflo(vw), bfhi(vw)};
                    *(unsigned*)(KS + (((size_t)b * 576 + 512 + s) * 16 + h) * 128 + 2 * lane) = kn; }
            }
            if (row0 < MP) { const int b = row0 >> 12, s0 = row0 & 4095; vt_dst = VTP + ((size_t)(b * 16 + h) * 128) * 4096 + s0; vt_ld = 4096; }
            else { const int b = (row0 - MP) >> 6; vt_dst = VTS + ((size_t)(b * 16 + h) * 128) * 576 + 512; vt_ld = 576; }
        } else {
            const int it = item - n_main, b = it >> 7, h = (it >> 3) & 15, jc = it & 7;
#pragma unroll
            for (int i = 0; i < 8; ++i) { const int t = wid * 8 + i;
                *(unsigned*)(KS + (((size_t)b * 576 + jc * 64 + t) * 16 + h) * 128 + 2 * lane) = cvt_pk_bf16(__uint_as_float(cur[i]), __uint_as_float(cur[8 + i]));
                *(LAS unsigned*)(tv + t * 130 + 2 * lane) = cvt_pk_bf16(__uint_as_float(cur[16 + i]), __uint_as_float(cur[24 + i]));
            }
            vt_dst = VTS + ((size_t)(b * 16 + h) * 128) * 576 + jc * 64; vt_ld = 576;
        }
        if (item + G < n_items) EC_ISSUE(nxt, item + G);
        __syncthreads();
        { const int d = tid >> 2, tg = tid & 3; unsigned w[8];
#pragma unroll
          for (int e = 0; e < 8; ++e) w[e] = (unsigned)tv[(16 * tg + 2 * e) * 130 + d] | ((unsigned)tv[(16 * tg + 2 * e + 1) * 130 + d] << 16);
          bf16_t* dp = vt_dst + (size_t)d * vt_ld + 16 * tg;
          *(u32x4*)dp = (u32x4){w[0], w[1], w[2], w[3]}; *(u32x4*)(dp + 8) = (u32x4){w[4], w[5], w[6], w[7]}; }
        __syncthreads();
#pragma unroll
        for (int i = 0; i < 32; ++i) cur[i] = nxt[i];
    }
#undef EC_ISSUE
}

__device__ __forceinline__ void phase_att_sample(const Params& P, int wv) {
    unsigned char* ws = P.ws; const bf16_t* QKV = (const bf16_t*)(ws + AR_QKV); const bf16_t* VTP = (const bf16_t*)(ws + AR_VTP); const bf16_t* VTS = (const bf16_t*)(ws + AR_VTS);
    const bf16_t* KS = (const bf16_t*)(ws + AR_KS); bf16_t* OATT = (bf16_t*)(ws + AR_OATT); const float* relb = P.in[I_RELB];
    const int tid_ = fresh_tid(wv), lane = tid_ & 63, fr = lane & 15, fq = lane >> 4, gw = (tid_ >> 6) * gridDim.x + blockIdx.x, nw = gridDim.x * 8;
    const int n_items = (MT / 64) * 16;
    for (int wi = 4096 * 2 + gw; wi < n_items * 2; wi += nw) {
        const int item = wi >> 1, qs = wi & 1;
        int c, h, row0, kstride, vstride; const bf16_t* Kb; const bf16_t* Vb;
        if (item < 4096) { const int b = item >> 10; c = (item >> 4) & 63; h = item & 15; row0 = b * 4096 + c * 64 + qs * 32;
            Kb = QKV + (size_t)(b * 4096) * 6144 + 2048 + h * 128; kstride = 6144; Vb = VTP + ((size_t)(b * 16 + h) * 128) * 4096; vstride = 4096; }
        else { const int it = item - 4096, b = it >> 4; h = it & 15; c = 8; row0 = MP + b * 64 + qs * 32;
            Kb = KS + (size_t)(b * 576) * 2048 + h * 128; kstride = 2048; Vb = VTS + ((size_t)(b * 16 + h) * 128) * 576; vstride = 576; }
        const float* bias = relb + h * 257;
        bf16x8 qf[2][4];
#pragma unroll
        for (int qt = 0; qt < 2; ++qt) { const bf16_t* qp = QKV + (size_t)(row0 + 16 * qt + fr) * 6144 + h * 128 + 8 * fq;
#pragma unroll
            for (int ks = 0; ks < 4; ++ks) qf[qt][ks] = *(const bf16x8*)(qp + 32 * ks); }
        const int qpos0 = c * 64 + qs * 32 + fr;
        float bmx = fmaxf(fmaxf(bias[lane], bias[lane + 64]), fmaxf(bias[lane + 128], bias[lane + 192])); bmx = fmaxf(bmx, bias[256]);
        bmx = fmaxf(bmx, __shfl_xor(bmx, 1)); bmx = fmaxf(bmx, __shfl_xor(bmx, 2)); bmx = fmaxf(bmx, __shfl_xor(bmx, 4)); bmx = fmaxf(bmx, __shfl_xor(bmx, 8)); bmx = fmaxf(bmx, __shfl_xor(bmx, 16)); bmx = fmaxf(bmx, __shfl_xor(bmx, 32));
        float mfix[2];
#pragma unroll
        for (int qt = 0; qt < 2; ++qt) { float q2 = 0.f;
#pragma unroll
            for (int ks = 0; ks < 4; ++ks)
#pragma unroll
                for (int e = 0; e < 8; ++e) { const float v = bf2f((bf16_t)qf[qt][ks][e]); q2 += v * v; }
            q2 += __shfl_xor(q2, 16); q2 += __shfl_xor(q2, 32);
            mfix[qt] = 16.0f * sqrtf(q2) + bmx; }
        float l_run[2] = {0.f, 0.f};
        f32x4 o[2][8];
#pragma unroll
        for (int qt = 0; qt < 2; ++qt)
#pragma unroll
            for (int dt = 0; dt < 8; ++dt) o[qt][dt] = (f32x4){0.f, 0.f, 0.f, 0.f};
        const int kc0 = c > 8 ? c - 8 : 0, kb_end = (c + 1) * 2;
        bf16x8 kf[2][4];
#define ATT_LOADK(KF, kb_) do { const int k0_ = (kb_) * 32; \
            _Pragma("unroll") for (int t = 0; t < 2; ++t) { const bf16_t* kp = Kb + (size_t)(k0_ + 8 * (fr >> 2) + 4 * t + (fr & 3)) * kstride + 8 * fq; \
                _Pragma("unroll") for (int ks = 0; ks < 4; ++ks) KF[t][ks] = *(const bf16x8*)(kp + 32 * ks); } } while (0)
        ATT_LOADK(kf, kc0 * 2);
        for (int kb = kc0 * 2; kb < kb_end; ++kb) {
            const int k0 = kb * 32;
            bf16x8 vf[8];
            { const bf16_t* vp = Vb + (size_t)fr * vstride + k0 + 8 * fq;
#pragma unroll
              for (int dt = 0; dt < 8; ++dt) vf[dt] = *(const bf16x8*)(vp + (size_t)(16 * dt) * vstride); }
            f32x4 s[2][2];
#pragma unroll
            for (int qt = 0; qt < 2; ++qt)
#pragma unroll
                for (int t = 0; t < 2; ++t) { s[qt][t] = (f32x4){0.f, 0.f, 0.f, 0.f};
#pragma unroll
                    for (int ks = 0; ks < 4; ++ks) s[qt][t] = __builtin_amdgcn_mfma_f32_16x16x32_bf16(kf[t][ks], qf[qt][ks], s[qt][t], 0, 0, 0); }
            ATT_LOADK(kf, kb + 1 < kb_end ? kb + 1 : kb);
            const bool far = qpos0 - (k0 + 31) >= 128;
#pragma unroll
            for (int qt = 0; qt < 2; ++qt) {
                const int qpos = qpos0 + 16 * qt; const float mf = mfix[qt];
                float ps = 0.f;
                if (far) { const float bfar = bias[256] - mf;
#pragma unroll
                    for (int t = 0; t < 2; ++t)
#pragma unroll
                        for (int r = 0; r < 4; ++r) { s[qt][t][r] = __expf(s[qt][t][r] + bfar); ps += s[qt][t][r]; }
                } else {
#pragma unroll
                    for (int t = 0; t < 2; ++t)
#pragma unroll
                        for (int r = 0; r < 4; ++r) { int rel = qpos - (k0 + 8 * fq + 4 * t + r); rel = rel > 128 ? 128 : (rel < -128 ? -128 : rel); s[qt][t][r] = __expf(s[qt][t][r] + bias[rel + 128] - mf); ps += s[qt][t][r]; }
                }
                l_run[qt] += ps;
                u32x4 pw; pw.x = cvt_pk_bf16(s[qt][0][0], s[qt][0][1]); pw.y = cvt_pk_bf16(s[qt][0][2], s[qt][0][3]); pw.z = cvt_pk_bf16(s[qt][1][0], s[qt][1][1]); pw.w = cvt_pk_bf16(s[qt][1][2], s[qt][1][3]);
                bf16x8 pf; __builtin_memcpy(&pf, &pw, 16);
#pragma unroll
                for (int dt = 0; dt < 8; ++dt) o[qt][dt] = __builtin_amdgcn_mfma_f32_16x16x32_bf16(vf[dt], pf, o[qt][dt], 0, 0, 0);
            }
        }
#undef ATT_LOADK
#pragma unroll
        for (int qt = 0; qt < 2; ++qt) {
            float lt = l_run[qt]; lt += __shfl_xor(lt, 16); lt += __shfl_xor(lt, 32);
            const float inv = 1.0f / lt;
            bf16_t* op = OATT + (size_t)(row0 + 16 * qt + fr) * DM + h * 128 + 4 * fq;
#pragma unroll
            for (int dt = 0; dt < 8; ++dt) { const f32x4 v = o[qt][dt] * inv; u32x2 w; w.x = cvt_pk_bf16(v[0], v[1]); w.y = cvt_pk_bf16(v[2], v[3]); *(u32x2*)(op + 16 * dt) = w; }
        }
    }
}

__device__ __forceinline__ void phase_att(const Params& P, int wv, LAS unsigned char* lds) {
    unsigned char* ws = P.ws; const bf16_t* QKV = (const bf16_t*)(ws + AR_QKV); const bf16_t* VTP = (const bf16_t*)(ws + AR_VTP); bf16_t* OATT = (bf16_t*)(ws + AR_OATT); const float* relb = P.in[I_RELB];
    const int tid_ = fresh_tid(wv), lane = tid_ & 63, fr = lane & 15, fq = lane >> 4, wid = __builtin_amdgcn_readfirstlane(tid_ >> 6);
    LAS float* lbias = (LAS float*)(lds + 65536);
    for (int wgi = blockIdx.x; wgi < 4 * 16 * 16; wgi += gridDim.x) {
        const int b = wgi >> 8, h = (wgi >> 4) & 15, cq = wgi & 15, c = 4 * cq + (wid >> 1), qs = wid & 1, row0 = b * 4096 + c * 64 + qs * 32;
        const bf16_t* Kb = QKV + (size_t)(b * 4096) * 6144 + 2048 + h * 128; const bf16_t* Vb = VTP + ((size_t)(b * 16 + h) * 128) * 4096; const int kstride = 6144, vstride = 4096;
        const float* bias = relb + h * 257;
        bf16x8 qf[2][4];
#pragma unroll
        for (int qt = 0; qt < 2; ++qt) { const bf16_t* qp = QKV + (size_t)(row0 + 16 * qt + fr) * 6144 + h * 128 + 8 * fq;
#pragma unroll
            for (int ks = 0; ks < 4; ++ks) qf[qt][ks] = *(const bf16x8*)(qp + 32 * ks); }
        const int qpos0 = c * 64 + qs * 32 + fr;
        float bmx = fmaxf(fmaxf(bias[lane], bias[lane + 64]), fmaxf(bias[lane + 128], bias[lane + 192])); bmx = fmaxf(bmx, bias[256]);
        bmx = fmaxf(bmx, __shfl_xor(bmx, 1)); bmx = fmaxf(bmx, __shfl_xor(bmx, 2)); bmx = fmaxf(bmx, __shfl_xor(bmx, 4)); bmx = fmaxf(bmx, __shfl_xor(bmx, 8)); bmx = fmaxf(bmx, __shfl_xor(bmx, 16)); bmx = fmaxf(bmx, __shfl_xor(bmx, 32));
        float mfix[2];
#pragma unroll
        for (int qt = 0; qt < 2; ++qt) { float q2 = 0.f;
#pragma unroll
            for (int ks = 0; ks < 4; ++ks)
#pragma unroll
                for (int e = 0; e < 8; ++e) { const float v = bf2f((bf16_t)qf[qt][ks][e]); q2 += v * v; }
            q2 += __shfl_xor(q2, 16); q2 += __shfl_xor(q2, 32);
            mfix[qt] = 16.0f * sqrtf(q2) + bmx; }
        float l_run[2] = {0.f, 0.f};
        f32x4 o[2][8];
#pragma unroll
        for (int qt = 0; qt < 2; ++qt)
#pragma unroll
            for (int dt = 0; dt < 8; ++dt) o[qt][dt] = (f32x4){0.f, 0.f, 0.f, 0.f};
        const int kt0 = cq >= 2 ? 4 * cq - 8 : 0, kt1 = 4 * cq + 3;
        bf16x8 pre[4];
#define ATT_FETCH(kt_) do { const int k0_ = (kt_) * 64 + 32 * ((wid & 3) >> 1); \
            if (wid < 4) { const bf16_t* kp = Kb + (size_t)(k0_ + 8 * (fr >> 2) + 4 * (wid & 1) + (fr & 3)) * kstride + 8 * fq; \
                _Pragma("unroll") for (int j = 0; j < 4; ++j) pre[j] = *(const bf16x8*)(kp + 32 * j); } \
            else { const bf16_t* vp = Vb + (size_t)(64 * (wid & 1) + fr) * vstride + k0_ + 8 * fq; \
                _Pragma("unroll") for (int j = 0; j < 4; ++j) pre[j] = *(const bf16x8*)(vp + (size_t)(16 * j) * vstride); } } while (0)
#define ATT_PARK(buf_) do { _Pragma("unroll") for (int j = 0; j < 4; ++j) *(LAS bf16x8*)(lds + (buf_) * 32768 + (4 * wid + j) * 1024 + lane * 16) = pre[j]; } while (0)
        __syncthreads();
        ATT_FETCH(kt0); ATT_PARK(0);
        if (tid_ < 257) lbias[tid_] = bias[tid_];
        __syncthreads();
        for (int kt = kt0; kt <= kt1; ++kt) {
            const int buf = (kt - kt0) & 1;
            if (kt < kt1) ATT_FETCH(kt + 1);
            if (kt >= c - 8 && kt <= c) {
#pragma unroll
                for (int blk = 0; blk < 2; ++blk) {
                    const int k0 = kt * 64 + 32 * blk;
                    const LAS unsigned char* fb = lds + buf * 32768 + lane * 16;
                    bf16x8 kf[2][4], vf[8];
#pragma unroll
                    for (int t = 0; t < 2; ++t)
#pragma unroll
                        for (int ks = 0; ks < 4; ++ks) kf[t][ks] = *(const LAS bf16x8*)(fb + (blk * 8 + t * 4 + ks) * 1024);
#pragma unroll
                    for (int dt = 0; dt < 8; ++dt) vf[dt] = *(const LAS bf16x8*)(fb + (16 + blk * 8 + dt) * 1024);
                    f32x4 s[2][2];
                    __builtin_amdgcn_s_setprio(1);
#pragma unroll
                    for (int qt = 0; qt < 2; ++qt)
#pragma unroll
                        for (int t = 0; t < 2; ++t) { s[qt][t] = (f32x4){0.f, 0.f, 0.f, 0.f};
#pragma unroll
                            for (int ks = 0; ks < 4; ++ks) s[qt][t] = __builtin_amdgcn_mfma_f32_16x16x32_bf16(kf[t][ks], qf[qt][ks], s[qt][t], 0, 0, 0); }
                    __builtin_amdgcn_s_setprio(0);
                    const bool far = qpos0 - (k0 + 31) >= 128;
#pragma unroll
                    for (int qt = 0; qt < 2; ++qt) {
                        const int qpos = qpos0 + 16 * qt; const float mf = mfix[qt];
                        float ps = 0.f;
                        if (far) { const float bfar = bias[256] - mf;
#pragma unroll
                            for (int t = 0; t < 2; ++t)
#pragma unroll
                                for (int r = 0; r < 4; ++r) { s[qt][t][r] = __expf(s[qt][t][r] + bfar); ps += s[qt][t][r]; }
                        } else {
#pragma unroll
                            for (int t = 0; t < 2; ++t)
#pragma unroll
                                for (int r = 0; r < 4; ++r) { int rel = qpos - (k0 + 8 * fq + 4 * t + r); rel = rel > 128 ? 128 : (rel < -128 ? -128 : rel); s[qt][t][r] = __expf(s[qt][t][r] + lbias[rel + 128] - mf); ps += s[qt][t][r]; }
                        }
                        l_run[qt] += ps;
                        u32x4 pw; pw.x = cvt_pk_bf16(s[qt][0][0], s[qt][0][1]); pw.y = cvt_pk_bf16(s[qt][0][2], s[qt][0][3]); pw.z = cvt_pk_bf16(s[qt][1][0], s[qt][1][1]); pw.w = cvt_pk_bf16(s[qt][1][2], s[qt][1][3]);
                        bf16x8 pf; __builtin_memcpy(&pf, &pw, 16);
                        __builtin_amdgcn_s_setprio(1);
#pragma unroll
                        for (int dt = 0; dt < 8; ++dt) o[qt][dt] = __builtin_amdgcn_mfma_f32_16x16x32_bf16(vf[dt], pf, o[qt][dt], 0, 0, 0);
                        __builtin_amdgcn_s_setprio(0);
                    }
                }
            }
            if (kt < kt1) ATT_PARK(buf ^ 1);
            __syncthreads();
        }
#undef ATT_FETCH
#undef ATT_PARK
#pragma unroll
        for (int qt = 0; qt < 2; ++qt) {
            float lt = l_run[qt]; lt += __shfl_xor(lt, 16); lt += __shfl_xor(lt, 32);
            const float inv = 1.0f / lt;
            bf16_t* op = OATT + (size_t)(row0 + 16 * qt + fr) * DM + h * 128 + 4 * fq;
#pragma unroll
            for (int dt = 0; dt < 8; ++dt) { const f32x4 v = o[qt][dt] * inv; u32x2 w; w.x = cvt_pk_bf16(v[0], v[1]); w.y = cvt_pk_bf16(v[2], v[3]); *(u32x2*)(op + 16 * dt) = w; }
        }
    }
}
__device__ __forceinline__ void phase_qkn(const Params& P, int wv) {
    unsigned char* ws = P.ws; bf16_t* QKVP = (bf16_t*)(ws + AR_QKVP); const bf16_t* HALO = (const bf16_t*)(ws + AR_HALO); const float* wconv = P.in[I_WBCONV]; const float* histB = P.in[I_STBC];
    const int tid_ = fresh_tid(wv), lane = tid_ & 63, gw = blockIdx.x * 8 + (tid_ >> 6), nw = gridDim.x * 8;
    constexpr int NWI = (MT / 64) * 32;
    unsigned raw[64], nraw[64];
#define QKN_LOAD(BUF, wi_) do { const unsigned* rp_ = (const unsigned*)(QKVP + (size_t)(((wi_) >> 5) * 64) * DNC + ((wi_) & 31) * 128 + 2 * lane); \
        _Pragma("unroll") for (int i = 0; i < 64; ++i) BUF[i] = rp_[(size_t)i * (DNC / 2)]; } while (0)
#pragma unroll
    for (int i = 0; i < 64; ++i) { raw[i] = 0u; nraw[i] = 0u; }
    int wi = gw;
    if (wi < NWI) QKN_LOAD(raw, wi);
    for (; wi < NWI; wi += nw) {
        const int ch = wi >> 5, sl = wi & 31, col = sl * 128 + 2 * lane, r0 = ch * 64; int b, s0, S; row_pos(r0, b, s0, S);
        float w0[4], w1[4];
#pragma unroll
        for (int j = 0; j < 4; ++j) { w0[j] = wconv[j * DNC + col]; w1[j] = wconv[j * DNC + col + 1]; }
        float a0[3], a1[3];
#pragma unroll
        for (int j = 0; j < 3; ++j) {
            if (s0 > 0) { const unsigned hw = *(const unsigned*)(HALO + ((size_t)(ch - 1) * 3 + j) * 4096 + col); a0[j] = bflo(hw); a1[j] = bfhi(hw); }
            else if (r0 >= MP) { const float* hp = histB + ((size_t)b * 3 + j) * DNC + col; a0[j] = hp[0]; a1[j] = hp[1]; }
            else { a0[j] = 0.f; a1[j] = 0.f; }
        }
        if (wi + nw < NWI) QKN_LOAD(nraw, wi + nw);
        const float qsc = sl < 16 ? 0.08838834764831845f : 1.0f;
        unsigned* rp = (unsigned*)(QKVP + (size_t)r0 * DNC + col);
#pragma unroll
        for (int i = 0; i < 64; ++i) {
            const float x0 = bflo(raw[i]), x1 = bfhi(raw[i]);
            float y0 = w0[0] * a0[0] + w0[1] * a0[1] + w0[2] * a0[2] + w0[3] * x0, y1 = w1[0] * a1[0] + w1[1] * a1[1] + w1[2] * a1[2] + w1[3] * x1;
            y0 = siluf_(y0); y1 = siluf_(y1);
            const float sc = rsqrtf(wave_sum(y0 * y0 + y1 * y1) + EPS) * qsc;
            rp[(size_t)i * (DNC / 2)] = cvt_pk_bf16(y0 * sc, y1 * sc);
            a0[0] = a0[1]; a0[1] = a0[2]; a0[2] = x0; a1[0] = a1[1]; a1[1] = a1[2]; a1[2] = x1;
        }
#pragma unroll
        for (int i = 0; i < 64; ++i) raw[i] = nraw[i];
    }
#undef QKN_LOAD
}

#include <type_traits>
typedef short bf16x4 __attribute__((ext_vector_type(4)));
template <int K> __device__ __forceinline__ f32x4 tile_mma(const LAS bf16_t* A, int lda, const LAS bf16_t* Bt, int ldb, int m0, int n0, f32x4 acc, int fr, int fq) {
#pragma unroll
    for (int k0 = 0; k0 < K; k0 += 32) {
        const bf16x8 a = *(const LAS bf16x8*)(A + (m0 + fr) * lda + k0 + 8 * fq);
        const bf16x8 b = *(const LAS bf16x8*)(Bt + (n0 + fr) * ldb + k0 + 8 * fq);
        acc = __builtin_amdgcn_mfma_f32_16x16x32_bf16(b, a, acc, 0, 0, 0);
    }
    return acc;
}
__device__ __forceinline__ f32x4 tile_mma16(const LAS bf16_t* A, int lda, const LAS bf16_t* Bt, int ldb, f32x4 acc, int fr, int fq) {
    const bf16x4 a = *(const LAS bf16x4*)(A + fr * lda + 4 * fq);
    const bf16x4 b = *(const LAS bf16x4*)(Bt + fr * ldb + 4 * fq);
    return __builtin_amdgcn_mfma_f32_16x16x16bf16_1k(b, a, acc, 0, 0, 0);
}
constexpr int DR_LD = 0, DR_MISC = 4352, DR_CW = 5376, DR_LB = 10496, DR_TB = 19712, DR_KN = 28928, DR_TT = DR_KN, DR_PT = DR_KN + 9216, DR_QN = 46336, DR_KDT = 63744, DR_RT = 82176, DR_VNT = 91392,
              DR_VBT = 100608, DR_AI = 109824, DR_ST = 119040, DR_END = 136448;

#ifdef DBG_DR_DUMP
#define DR_DUMP(slot) do { if (item == 8 && n == 0) { __syncthreads(); for (int i_ = tid0; i_ < DR_END / 4; i_ += NTH) ((unsigned*)(ws + WS_END))[(size_t)(slot) * (DR_END / 4) + i_] = ((const LAS unsigned*)lds)[i_]; __syncthreads(); } } while (0)
#else
#define DR_DUMP(slot) do { } while (0)
#endif
#ifdef DR_SETPRIO
#define DR_PRIO(x) __builtin_amdgcn_s_setprio(x)
#else
#define DR_PRIO(x) do { } while (0)
#endif
template <int SKIP = 0>
__device__ __forceinline__ void phase_dr(const Params& P, int wv, LAS unsigned char* lds) {
    unsigned char* ws = P.ws; const bf16_t* QKVP = (const bf16_t*)(ws + AR_QKVP); bf16_t* ODR = (bf16_t*)(ws + AR_ODR); const float* BA = (const float*)(ws + WS_BA);
    const float* wconv = P.in[I_WBCONV]; const float* histB = P.in[I_STBC];
    LAS float* LD = (LAS float*)(lds + DR_LD); LAS bf16_t* LB = (LAS bf16_t*)(lds + DR_LB); LAS bf16_t* TB = (LAS bf16_t*)(lds + DR_TB); LAS bf16_t* TT = (LAS bf16_t*)(lds + DR_TT); LAS bf16_t* PT = (LAS bf16_t*)(lds + DR_PT);
    LAS bf16_t* KN = (LAS bf16_t*)(lds + DR_KN); LAS bf16_t* QN = (LAS bf16_t*)(lds + DR_QN); LAS bf16_t* KDT = (LAS bf16_t*)(lds + DR_KDT); LAS bf16_t* RT = (LAS bf16_t*)(lds + DR_RT); LAS bf16_t* VNT = (LAS bf16_t*)(lds + DR_VNT);
    LAS bf16_t* VBT = (LAS bf16_t*)(lds + DR_VBT); LAS bf16_t* AI = (LAS bf16_t*)(lds + DR_AI); LAS bf16_t* ST = (LAS bf16_t*)(lds + DR_ST);
    LAS float* GC = (LAS float*)(lds + DR_MISC); LAS float* BETA = GC + 64; LAS float* EG = GC + 128; LAS float* BEG = GC + 192; LAS float* CW = (LAS float*)(lds + DR_CW);
    const int tid0 = fresh_tid(wv), lane0 = tid0 & 63, wid0 = __builtin_amdgcn_readfirstlane(tid0 >> 6);
    const __amdgpu_buffer_rsrc_t rsrc_ = __builtin_amdgcn_make_buffer_rsrc((void*)QKVP, 0, (int)((size_t)MT * DNC * 2), 0x00020000);
    for (int item = blockIdx.x; item < 256 + 1024; item += gridDim.x) {
        int b, hv, half, rowbase, nchunks; bool samp;
        if (item < 256) { samp = false; b = item >> 6; hv = (item >> 1) & 31; half = item & 1; rowbase = b * SEQ; nchunks = SEQ / 64; }
        else { const int it = item - 256; samp = true; b = it >> 6; hv = (it >> 1) & 31; half = it & 1; rowbase = MP + b * DSEQ; nchunks = 1; }
        const int hk = hv >> 1;
        { const int lane = launder_v(lane0), wid = launder_s(wid0);
          const int cq = hk * 128 + 2 * lane, ck = 2048 + hk * 128 + 2 * lane, cvv = 4096 + hv * 128 + half * 64 + lane;
          if (wid == 0) {
#pragma unroll
            for (int j = 0; j < 4; ++j) { CW[(j * 5 + 0) * 64 + lane] = wconv[j * DNC + cq]; CW[(j * 5 + 1) * 64 + lane] = wconv[j * DNC + cq + 1]; CW[(j * 5 + 2) * 64 + lane] = wconv[j * DNC + ck];
                CW[(j * 5 + 3) * 64 + lane] = wconv[j * DNC + ck + 1]; CW[(j * 5 + 4) * 64 + lane] = wconv[j * DNC + cvv]; }
          }
          for (int i = wid * 64 + lane; i < 64 * 36; i += NTH) ((LAS unsigned*)TB)[i] = 0u;
        }
        auto run_item = [&](auto role_tag) {
        constexpr int ROLE = decltype(role_tag)::value;
        const int lane_i = launder_v(lane0), wid_i = launder_s(wid0), smt = wid_i - 4;
        f32x4 sacc[8];
        float* ssm_out = (samp ? P.out + O_SBS : P.out + O_PBS) + ((size_t)(b * 32 + hv) * 128) * 128;
        { const int fr = lane_i & 15, fq = lane_i >> 4;
#pragma unroll
          for (int j = 0; j < 8; ++j) {
            if (ROLE == 1 && samp && wid_i >= 4) { const float* sp = P.in[I_STBS] + ((size_t)(b * 32 + hv) * 128) * 128 + half * 64 + 16 * smt + fr;
#pragma unroll
                for (int r = 0; r < 4; ++r) sacc[j][r] = sp[(size_t)(16 * j + 4 * fq + r) * 128]; }
            else sacc[j] = (f32x4){0.f, 0.f, 0.f, 0.f};
            u32x2 w; w.x = cvt_pk_bf16(sacc[j][0], sacc[j][1]); w.y = cvt_pk_bf16(sacc[j][2], sacc[j][3]);
            if (ROLE == 1 && wid_i >= 4) *(LAS u32x2*)(ST + (16 * smt + fr) * 136 + 16 * j + 4 * fq) = w;
          } }
        unsigned pq[10], pk[10], pd[10], pv[5]; float pgc = 0.f, pbeta = 0.f;
        unsigned rq[10], rk[10], rv[13]; float rbeta = 0.f, rg = 0.f;
#define DR_LOADRAW(nn) do { if constexpr (ROLE == 1 && !(SKIP & 2)) { const int lane = launder_v(lane0), wq_ = launder_s(wid0) - 1; \
            const int cq = hk * 128 + 2 * lane, ck = 2048 + hk * 128 + 2 * lane, cvv = 4096 + hv * 128 + half * 64 + lane; \
            const float* bap = BA + (size_t)(rowbase + (nn) * 64 + lane) * 64; rbeta = bap[hv]; rg = bap[32 + hv]; \
            const int t0 = wq_ == 0 ? 0 : 1 + 9 * wq_, cnt = wq_ == 0 ? 10 : 9, p0 = (nn) * 64 + t0 - 3; \
            _Pragma("unroll") for (int i = 0; i < 13; ++i) { const int p = p0 + i; \
                if (p >= 0 && i - 3 < cnt) { const unsigned so_ = (unsigned)(rowbase + p) * (unsigned)(DNC * 2);     \
                    if (i >= 3) { rq[i - 3] = __builtin_amdgcn_raw_buffer_load_b32(rsrc_, 2 * cq, so_, 0); rk[i - 3] = __builtin_amdgcn_raw_buffer_load_b32(rsrc_, 2 * ck, so_, 0); } \
                    rv[i] = (unsigned)(unsigned short)__builtin_amdgcn_raw_buffer_load_b16(rsrc_, 2 * cvv, so_, 0); } \
                else if (p < 0 && samp) { const float* hp = histB + ((size_t)b * 3 + (3 + p)) * DNC; rv[i] = (unsigned)f2bf(hp[cvv]); } \
                else { rv[i] = 0u; if (i >= 3) { rq[i - 3] = 0u; rk[i - 3] = 0u; } } } } } while (0)
#define DR_PRECOMPUTE(nn) do { if constexpr (ROLE == 1 && !(SKIP & 2)) { const int lane = launder_v(lane0), wq_ = launder_s(wid0) - 1; \
            pbeta = rbeta; float g_ = rg; \
            _Pragma("unroll") for (int d = 1; d < 64; d <<= 1) { const float v_ = __shfl_up(g_, d); if (lane >= d) g_ += v_; } \
            pgc = g_; const float gl_ = __int_as_float(__builtin_amdgcn_readlane(__float_as_int(g_), 63)); \
            float wvv[4]; \
            _Pragma("unroll") for (int j = 0; j < 4; ++j) wvv[j] = CW[(j * 5 + 4) * 64 + lane]; \
            const int t0 = wq_ == 0 ? 0 : 1 + 9 * wq_; \
            float xv[13]; unsigned cq_[10], ck_[10]; \
            _Pragma("unroll") for (int i = 0; i < 13; ++i) xv[i] = bflo(rv[i]); \
            _Pragma("unroll") for (int i = 0; i < 10; ++i) { cq_[i] = rq[i]; ck_[i] = rk[i]; } \
            if ((nn) + 1 < nchunks) DR_LOADRAW((nn) + 1);                             \
            _Pragma("unroll") for (int i = 0; i < 10; ++i) { \
                float v = 0.f; \
                _Pragma("unroll") for (int j = 0; j < 4; ++j) v += wvv[j] * xv[i + j]; \
                v = siluf_(v); \
                const float k0 = bflo(ck_[i]), k1 = bfhi(ck_[i]); \
                const int tt = t0 + i < 64 ? t0 + i : 63; const float gt_ = __int_as_float(__builtin_amdgcn_readlane(__float_as_int(g_), tt)), bt_ = __int_as_float(__builtin_amdgcn_readlane(__float_as_int(pbeta), tt)); \
                const float kd = __expf(gl_ - gt_); \
                pq[i] = cq_[i]; pk[i] = ck_[i]; pd[i] = cvt_pk_bf16(k0 * kd, k1 * kd); \
                if (i & 1) pv[i >> 1] |= ((unsigned)f2bf(v * bt_)) << 16; else pv[i >> 1] = (unsigned)f2bf(v * bt_); } } } while (0)
        __syncthreads();
        DR_LOADRAW(0);
        DR_PRECOMPUTE(0);
        __syncthreads();
        for (int n = 0; n < nchunks; ++n) {
            const int crow = rowbase + n * 64;
            if constexpr (ROLE == 1) { const int lane = launder_v(lane0), wq_ = launder_s(wid0) - 1, t0 = wq_ == 0 ? 0 : 1 + 9 * wq_, cnt = wq_ == 0 ? 10 : 9;
                if (wq_ == 0) { const float eg_ = __expf(pgc); GC[lane] = pgc; BETA[lane] = pbeta; EG[lane] = eg_; BEG[lane] = pbeta * eg_; }
#pragma unroll
                for (int i = 0; i < 10; ++i) { const int t = t0 + i;
                    if (i < cnt) { *(LAS unsigned*)(QN + t * 136 + 2 * lane) = pq[i]; *(LAS unsigned*)(KN + t * 136 + 2 * lane) = pk[i];
                        KDT[(2 * lane) * 72 + t] = (bf16_t)(pd[i] & 0xffffu); KDT[(2 * lane + 1) * 72 + t] = (bf16_t)(pd[i] >> 16);
                        VBT[lane * 72 + t] = (bf16_t)((i & 1) ? (pv[i >> 1] >> 16) : (pv[i >> 1] & 0xffffu)); } }
            }
            __syncthreads();
            DR_DUMP(0);
            if constexpr (!(SKIP & 4)) { const int lane = launder_v(lane0), wid = launder_s(wid0), fr = lane & 15, fq = lane >> 4;
#pragma unroll
            for (int e = 0; e < 2; ++e) {
                const int id = 2 * wid + e, mt = id >> 2, nt = id & 3, i = 16 * mt + fr, j0 = 16 * nt + 4 * fq;
                f32x4 la = (f32x4){0.f, 0.f, 0.f, 0.f}, aa = (f32x4){0.f, 0.f, 0.f, 0.f};
                if (nt <= mt) {
                    la = tile_mma<128>(KN, 136, KN, 136, 16 * mt, 16 * nt, la, fr, fq);
                    aa = tile_mma<128>(QN, 136, KN, 136, 16 * mt, 16 * nt, aa, fr, fq);
                    const float gi = GC[i], bi = BETA[i];
#pragma unroll
                    for (int r = 0; r < 4; ++r) { const int j = j0 + r; const float dec = j <= i ? __expf(gi - GC[j]) : 0.f; aa[r] *= dec; la[r] = j < i ? la[r] * dec * bi : 0.f; }
                    if (nt == mt) {
#pragma unroll
                        for (int r = 0; r < 4; ++r) LD[(mt * 16 + fr) * 17 + 4 * fq + r] = la[r]; }
                }
                u32x2 w; w.x = cvt_pk_bf16(la[0], la[1]); w.y = cvt_pk_bf16(la[2], la[3]); *(LAS u32x2*)(LB + i * 72 + j0) = w;
                w.x = cvt_pk_bf16(aa[0], aa[1]); w.y = cvt_pk_bf16(aa[2], aa[3]); *(LAS u32x2*)(AI + i * 72 + j0) = w;
                { const int dv = 16 * mt + fr; f32x4 ra = (f32x4){0.f, 0.f, 0.f, 0.f};
                  ra = tile_mma<128>(ST, 136, KN, 136, 16 * mt, 16 * nt, ra, fr, fq);
                  const u32x2 vb = *(const LAS u32x2*)(VBT + dv * 72 + j0);
                  w.x = cvt_pk_bf16(bflo(vb.x) - BEG[j0] * ra[0], bfhi(vb.x) - BEG[j0 + 1] * ra[1]); w.y = cvt_pk_bf16(bflo(vb.y) - BEG[j0 + 2] * ra[2], bfhi(vb.y) - BEG[j0 + 3] * ra[3]);
                  *(LAS u32x2*)(RT + dv * 72 + j0) = w; }
            } }
            __syncthreads();
            DR_DUMP(1);
            if constexpr (ROLE == 1) { if (n + 1 < nchunks) DR_PRECOMPUTE(n + 1); }
            else if constexpr (!(SKIP & 1)) {
                DR_PRIO(3);
                const int lane = launder_v(lane0), fr = lane & 15, fq = lane >> 4, bk = lane >> 4, c = lane & 15;
                float x[16];
#pragma unroll
                for (int i = 0; i < 16; ++i) { float a = (i == c) ? 1.0f : 0.f;
#pragma unroll
                    for (int j = 0; j < i; ++j) a -= LD[(bk * 16 + i) * 17 + j] * x[j];
                    x[i] = a; }
#pragma unroll
                for (int i = 0; i < 16; ++i) TB[(16 * bk + i) * 72 + 16 * bk + c] = f2bf(x[i]);
#pragma unroll
                for (int i = 0; i < 16; i += 2) *(LAS unsigned*)(TT + (16 * bk + c) * 72 + 16 * bk + i) = cvt_pk_bf16(x[i], x[i + 1]);
                { const int zr = 16 + (lane >> 2), zc = 4 * (lane & 3); *(LAS u32x2*)(TT + zr * 72 + zc) = (u32x2){0u, 0u}; }
                asm volatile("s_waitcnt lgkmcnt(0)" ::: "memory");
#pragma unroll
                for (int p = 0; p < 2; ++p) { const int lo = 32 * p, hi = 32 * p + 16;
                    f32x4 a = (f32x4){0.f, 0.f, 0.f, 0.f};
                    a = tile_mma16(LB + hi * 72 + lo, 72, TT + lo * 72 + lo, 72, a, fr, fq);
#pragma unroll
                    for (int r = 0; r < 4; ++r) PT[(16 * p + 4 * fq + r) * 40 + fr] = f2bf(a[r]);
                }
                asm volatile("s_waitcnt lgkmcnt(0)" ::: "memory");
#pragma unroll
                for (int p = 0; p < 2; ++p) { const int lo = 32 * p, hi = 32 * p + 16;
                    f32x4 a = (f32x4){0.f, 0.f, 0.f, 0.f};
                    a = tile_mma16(TB + hi * 72 + hi, 72, PT + (16 * p) * 40, 40, a, fr, fq);
                    u32x2 w; w.x = cvt_pk_bf16(-a[0], -a[1]); w.y = cvt_pk_bf16(-a[2], -a[3]); *(LAS u32x2*)(TB + (hi + fr) * 72 + lo + 4 * fq) = w;
#pragma unroll
                    for (int r = 0; r < 4; ++r) TT[(lo + 4 * fq + r) * 72 + hi + fr] = f2bf(-a[r]);
                }
                asm volatile("s_waitcnt lgkmcnt(0)" ::: "memory");
#pragma unroll
                for (int mt = 0; mt < 2; ++mt)
#pragma unroll
                    for (int nt = 0; nt < 2; ++nt) { f32x4 a = (f32x4){0.f, 0.f, 0.f, 0.f};
                        a = tile_mma<32>(LB + 32 * 72, 72, TT, 72, 16 * mt, 16 * nt, a, fr, fq);
#pragma unroll
                        for (int r = 0; r < 4; ++r) PT[(16 * nt + 4 * fq + r) * 40 + 16 * mt + fr] = f2bf(a[r]); }
                asm volatile("s_waitcnt lgkmcnt(0)" ::: "memory");
#pragma unroll
                for (int mt = 0; mt < 2; ++mt)
#pragma unroll
                    for (int nt = 0; nt < 2; ++nt) { f32x4 a = (f32x4){0.f, 0.f, 0.f, 0.f};
                        a = tile_mma<32>(TB + 32 * 72 + 32, 72, PT, 40, 16 * mt, 16 * nt, a, fr, fq);
                        u32x2 w; w.x = cvt_pk_bf16(-a[0], -a[1]); w.y = cvt_pk_bf16(-a[2], -a[3]); *(LAS u32x2*)(TB + (32 + 16 * mt + fr) * 72 + 16 * nt + 4 * fq) = w; }
                DR_PRIO(0);
            }
            __syncthreads();
            DR_DUMP(2);
            if constexpr (!(SKIP & 8)) { const int lane = launder_v(lane0), wid = launder_s(wid0), fr = lane & 15, fq = lane >> 4;
#pragma unroll
            for (int e = 0; e < 2; ++e) {
                const int id = 2 * wid + e, mt = id >> 2, nt = id & 3, dv = 16 * mt + fr, t0 = 16 * nt + 4 * fq;
                f32x4 a = (f32x4){0.f, 0.f, 0.f, 0.f};
                a = tile_mma<64>(RT, 72, TB, 72, 16 * mt, 16 * nt, a, fr, fq);
                u32x2 w; w.x = cvt_pk_bf16(a[0], a[1]); w.y = cvt_pk_bf16(a[2], a[3]);
                *(LAS u32x2*)(VNT + dv * 72 + t0) = w;
            } }
            __syncthreads();
            DR_DUMP(4);
            if constexpr (!(SKIP & 8)) { const int lane = launder_v(lane0), wid = launder_s(wid0), fr = lane & 15, fq = lane >> 4;
#pragma unroll
            for (int e = 0; e < 2; ++e) {
                const int id = 2 * wid + e, mt = id >> 2, nt = id & 3, i = 16 * mt + fr;
                f32x4 a = (f32x4){0.f, 0.f, 0.f, 0.f};
                a = tile_mma<128>(QN, 136, ST, 136, 16 * mt, 16 * nt, a, fr, fq);
                a = a * EG[i];
                a = tile_mma<64>(AI, 72, VNT, 72, 16 * mt, 16 * nt, a, fr, fq);
                u32x2 w; w.x = cvt_pk_bf16(a[0], a[1]); w.y = cvt_pk_bf16(a[2], a[3]);
                *(u32x2*)(ODR + (size_t)(crow + i) * DNV + hv * 128 + half * 64 + 16 * nt + 4 * fq) = w;
#ifdef DBG_DR_DUMP
                if (item == 8 && n == 0) *(f32x4*)((float*)(ws + WS_END + 5 * (size_t)DR_END) + i * 64 + 16 * nt + 4 * fq) = a;
#endif
            }
            { const float dl = EG[63];
              if (ROLE == 1 && wid >= 4) {
#pragma unroll
              for (int j = 0; j < 8; ++j) { sacc[j] = sacc[j] * dl; sacc[j] = tile_mma<64>(VNT, 72, KDT, 72, 16 * smt, 16 * j, sacc[j], fr, fq); } } }
            __syncthreads();
#pragma unroll
            for (int j = 0; j < 8; ++j) { u32x2 w; w.x = cvt_pk_bf16(sacc[j][0], sacc[j][1]); w.y = cvt_pk_bf16(sacc[j][2], sacc[j][3]); if (ROLE == 1 && wid >= 4) *(LAS u32x2*)(ST + (16 * smt + fr) * 136 + 16 * j + 4 * fq) = w; }
            }
        }
        __syncthreads();
        { const int fr = lane_i & 15, fq = lane_i >> 4;
        if (ROLE == 1 && wid_i >= 4) {
#pragma unroll
        for (int j = 0; j < 8; ++j)
#pragma unroll
            for (int r = 0; r < 4; ++r) ssm_out[(size_t)(16 * j + 4 * fq + r) * 128 + half * 64 + 16 * smt + fr] = sacc[j][r];
        } }
#undef DR_PRECOMPUTE
#undef DR_LOADRAW
        };
        if (wid0 < 1) run_item(std::integral_constant<int, 0>{}); else run_item(std::integral_constant<int, 1>{});
        __syncthreads();
    }
}

__device__ __forceinline__ void phase_eb(const Params& P, int wv) {
    unsigned char* ws = P.ws; bf16_t* ODR = (bf16_t*)(ws + AR_ODR); const bf16_t* Z = (const bf16_t*)(ws + AR_Z); const float* go = P.in[I_GBOUT];
    const int tid_ = fresh_tid(wv), lane = tid_ & 63, gw = blockIdx.x * 8 + (tid_ >> 6), nw = gridDim.x * 8;
    float g[8];
#pragma unroll
    for (int e = 0; e < 8; ++e) g[e] = go[(lane & 15) * 8 + e];
    u32x4 co[8], cz[8], no_[8], nz[8];
#define EB_LOAD(O_, Z_, row_) do { _Pragma("unroll") for (int it = 0; it < 8; ++it) { const size_t off_ = (size_t)(row_) * DNV + (it * 64 + lane) * 8; O_[it] = *(const u32x4*)(ODR + off_); Z_[it] = *(const u32x4*)(Z + off_); } } while (0)
#pragma unroll
    for (int it = 0; it < 8; ++it) { co[it] = (u32x4){0u, 0u, 0u, 0u}; cz[it] = co[it]; no_[it] = co[it]; nz[it] = co[it]; }
    int row = gw;
    if (row < MT) EB_LOAD(co, cz, row);
    for (; row < MT; row += nw) {
        if (row + nw < MT) EB_LOAD(no_, nz, row + nw);
#pragma unroll
        for (int it = 0; it < 8; ++it) {
            const size_t off = (size_t)row * DNV + (it * 64 + lane) * 8;
            float o[8], z[8];
            o[0] = bflo(co[it].x); o[1] = bfhi(co[it].x); o[2] = bflo(co[it].y); o[3] = bfhi(co[it].y); o[4] = bflo(co[it].z); o[5] = bfhi(co[it].z); o[6] = bflo(co[it].w); o[7] = bfhi(co[it].w);
            z[0] = bflo(cz[it].x); z[1] = bfhi(cz[it].x); z[2] = bflo(cz[it].y); z[3] = bfhi(cz[it].y); z[4] = bflo(cz[it].z); z[5] = bfhi(cz[it].z); z[6] = bflo(cz[it].w); z[7] = bfhi(cz[it].w);
            float sq = 0.f;
#pragma unroll
            for (int e = 0; e < 8; ++e) sq += o[e] * o[e];
            sq += __shfl_xor(sq, 1); sq += __shfl_xor(sq, 2); sq += __shfl_xor(sq, 4); sq += __shfl_xor(sq, 8);
            const float rs = rsqrtf(sq * (1.0f / 128.0f) + EPS);
#pragma unroll
            for (int e = 0; e < 8; ++e) o[e] = o[e] * rs * g[e] * siluf_(z[e]);
            u32x4 w; w.x = cvt_pk_bf16(o[0], o[1]); w.y = cvt_pk_bf16(o[2], o[3]); w.z = cvt_pk_bf16(o[4], o[5]); w.w = cvt_pk_bf16(o[6], o[7]);
            *(u32x4*)(ODR + off) = w;
        }
#pragma unroll
        for (int it = 0; it < 8; ++it) { co[it] = no_[it]; cz[it] = nz[it]; }
    }
#undef EB_LOAD
}
constexpr int LDS_BYTES = 147456;
static_assert(DR_END + 16 <= LDS_BYTES && pg8::STAGE_BYTES + 16 <= LDS_BYTES, "lds");
#ifndef TAILK
#define TAILK true
#endif
constexpr int NPH = 1 + 4 * 13 + 1;

__global__ void __launch_bounds__(NTH, 2) mega(Params P0) {
    extern __shared__ __attribute__((aligned(16))) unsigned char lds_raw[];
    LAS unsigned char* lds = (LAS unsigned char*)lds_raw;
    unsigned char* ws0 = P0.ws;
    const int wv = __builtin_amdgcn_readfirstlane((int)threadIdx.x >> 6);
    volatile LAS unsigned* xbw = (volatile LAS unsigned*)(lds + LDS_BYTES - 16);
    if (threadIdx.x == 0) { xbw[0] = 0u; xbw[1] = 0u; xbw[2] = 0u; xbw[3] = 0u; }
    __syncthreads();
    XcdBarrier bar = xcd_barrier_post((unsigned*)(ws0 + WS_CTL), xbw);
#define SSV(k) (SS + (size_t)(k) * MT)
    bool need_bar = false;
#ifdef TS_A
#define TS_CAP(p) do { if (((p) == TS_A || (p) == TS_B) && launder_s((int)blockIdx.x) == 0 && fresh_tid(wv) == 0) ((volatile unsigned long long*)(P0.ws + WS_CTL + 32768))[(p) == TS_B ? 1 : 0] = __builtin_amdgcn_s_memrealtime(); } while (0)
#else
#define TS_CAP(p) do { } while (0)
#endif
    int hbsel = 0;
    int ph = 0;
#define PHASE_BEGIN(active) if ((active) && ph >= P0.pb && ph < P0.pe) { if (need_bar) xcd_barrier(bar, wv); need_bar = true; TS_CAP(ph); asm volatile("; === PHASE SITE line %0" :: "n"(__LINE__)); const Params& P = P0; unsigned char* ws = P.ws; asm volatile("" : "+s"(ws)); \
        float* H = (float*)(ws + WS_H); bf16_t* HB = (bf16_t*)(ws + WS_HB + (size_t)(hbsel & 1) * HB_STRIDE); bf16_t* HBN = (bf16_t*)(ws + WS_HB + (size_t)((hbsel + 1) & 1) * HB_STRIDE); (void)HBN; ssq_t* SS = (ssq_t*)(ws + WS_SS); const int G = launder_s((int)gridDim.x), wg = launder_s((int)blockIdx.x); (void)H; (void)HB; (void)SS; (void)G; (void)wg;
#define PHASE_END } ++ph;

#ifndef REPEAT
#define REPEAT -1
#endif
#define REP(k, ...) do { if (REPEAT == (k)) { xcd_barrier(bar, wv); __VA_ARGS__; } } while (0)
    PHASE_BEGIN(true) phase_prologue(P, wv, lds); REP(0, phase_prologue(P, wv, lds)); if (REPEAT == 99) { for (int i_ = 0; i_ < 32; ++i_) xcd_barrier(bar, wv); } PHASE_END

    for (int L = 0; L < 4; ++L) {
        hbsel = L;
        const int kind = L % 3, ja = L / 3;
        PHASE_BEGIN(kind == 0) {
            pg8::Gemm g{HB, (const bf16_t*)(ws + WS_WAIN) + (size_t)ja * 6144 * 2048, MT, 6144, 2048};
            pg8::StaticOrder S; S.init(MT, 6144, 2048, G, wg, false);
            EpiA1 E{SSV(3 * L), (bf16_t*)(ws + AR_BG), (bf16_t*)(ws + AR_CV), P.out + O_PA + (size_t)ja * NBP * 2 * DM, P.out + O_SA + (size_t)ja * NBS * 2 * DM};
            pg8::gemm_phase(lds, g, S, E, wv);
            if (L == 0) REP(1, pg8::gemm_phase(lds, g, S, E, wv));
            if (L == 0) REP(11, pg8::gemm_phase(lds, g, S, EpiNull{}, wv));
            if (L == 0) REP(12, { pg8::Gemm g2 = g; g2.bmul = 0; pg8::gemm_phase(lds, g2, S, EpiNull{}, wv); });
            if (L == 0) REP(13, { pg8::Gemm g2 = g; g2.bmul = 0; g2.amul = 0; pg8::gemm_phase(lds, g2, S, EpiNull{}, wv); });
#define RX_(...) { xcd_barrier(bar, wv); pg8::gemm_phase(lds, g, S, E, wv); __VA_ARGS__; }
            if (L == 0 && REPEAT == 21) { RX_() RX_() RX_() RX_() }
            if (L == 0 && REPEAT == 25) { for (int r_ = 0; r_ < 8; ++r_) { xcd_barrier(bar, wv); prep_fill<1>(P, wv, lds, S.nwg, launder_s(G), launder_s(wg)); } }
            if (L == 0 && REPEAT == 22) { RX_(prep_fill<99>(P, wv, lds, S.nwg, launder_s(G), launder_s(wg))) RX_(prep_fill<99>(P, wv, lds, S.nwg, launder_s(G), launder_s(wg))) RX_(prep_fill<99>(P, wv, lds, S.nwg, launder_s(G), launder_s(wg))) RX_(prep_fill<99>(P, wv, lds, S.nwg, launder_s(G), launder_s(wg))) }
#undef RX_
            if (L == 0) prep_fill<1>(P, wv, lds, S.nwg, launder_s(G), launder_s(wg)); else prep_fill<7>(P, wv, lds, S.nwg, launder_s(G), launder_s(wg));
        } PHASE_END
        PHASE_BEGIN(kind != 0) {
            pg8::Gemm g; pg8::StaticOrder S; EpiRowScale E;
            if (kind == 1) { g = pg8::Gemm{HB, (const bf16_t*)(ws + WS_WBIN), MT, 12288, 2048};
                E = EpiRowScale{SSV(3 * L), (bf16_t*)(ws + AR_QKVP), DNC, DNC, (bf16_t*)(ws + AR_Z), DNV, 3, DNC, P.out + O_PBC, P.out + O_SBC, (bf16_t*)(ws + AR_HALO)}; }
            else { g = pg8::Gemm{HB, (const bf16_t*)(ws + WS_WCQKV), MT, 6144, 2048};
                E = EpiRowScale{SSV(3 * L), (bf16_t*)(ws + AR_QKV), 6144, 1 << 30, nullptr, 0, 0, 0, nullptr, nullptr, nullptr}; }
            S.init(MT, g.N, 2048, G, wg, false);
            pg8::gemm_phase(lds, g, S, E, wv);
            if (kind == 1) prep_fill<3>(P, wv, lds, S.nwg, launder_s(G), launder_s(wg)); else prep_fill<5>(P, wv, lds, S.nwg, launder_s(G), launder_s(wg));
        } PHASE_END
        PHASE_BEGIN(kind == 1) { phase_ba(P, wv, SSV(3 * L), HB); phase_qkn(P, wv); } PHASE_END
        PHASE_BEGIN(true) {
            if (kind == 0) { phase_ea(P, wv, ja); if (L == 0) REP(2, phase_ea(P, wv, ja)); if (L == 0 && REPEAT == 26) { for (int r_ = 0; r_ < 8; ++r_) { xcd_barrier(bar, wv); phase_ea(P, wv, ja); } } }
            else if (kind == 1) {
#if REPEAT >= 30 && REPEAT < 46
                phase_dr<REPEAT - 30>(P, wv, lds); xcd_barrier(bar, wv);
#endif
                phase_dr(P, wv, lds); REP(3, phase_dr(P, wv, lds)); if (REPEAT == 46) { for (int r_ = 0; r_ < 4; ++r_) { xcd_barrier(bar, wv); phase_dr(P, wv, lds); } } }
            else phase_ec(P, wv, lds);
        } PHASE_END
        PHASE_BEGIN(kind != 0) {
            if (kind == 1) phase_eb(P, wv);
            else { phase_att(P, wv, lds); phase_att_sample(P, wv); REP(4, { phase_att(P, wv, lds); phase_att_sample(P, wv); }); if (REPEAT == 29) { for (int r_ = 0; r_ < 8; ++r_) { xcd_barrier(bar, wv); phase_att(P, wv, lds); phase_att_sample(P, wv); } } }
        } PHASE_END
        PHASE_BEGIN(true) {
            pg8::Gemm g;
            if (kind == 0) g = pg8::Gemm{(const bf16_t*)(ws + AR_AA), (const bf16_t*)(ws + WS_WAOUT) + (size_t)ja * 2048 * 2048, MT, 2048, 2048};
            else if (kind == 1) g = pg8::Gemm{(const bf16_t*)(ws + AR_ODR), (const bf16_t*)(ws + WS_WBOUT), MT, 2048, 4096};
            else g = pg8::Gemm{(const bf16_t*)(ws + AR_OATT), (const bf16_t*)(ws + WS_WCOUT), MT, 2048, 2048};
            pg8::StaticOrder S; S.init(MT, 2048, g.K, G, wg, TAILK);
            EpiResid<false> E{H, HB, HB, SSV(3 * L + 1), nullptr, nullptr};
            pg8::gemm_phase(lds, g, S, E, wv, (float*)(ws + (kind != 0 ? AR_PART_B : AR_PART)));
        } PHASE_END
        PHASE_BEGIN(TAILK) phase_reduce(P, wv, kind == 1 ? 4096 : 2048, (const float*)(ws + (kind != 0 ? AR_PART_B : AR_PART)), SSV(3 * L + 1), nullptr, HB, HB);
            if (L == 0 && REPEAT == 27) { for (int r_ = 0; r_ < 16; ++r_) { xcd_barrier(bar, wv); phase_reduce(P, wv, 2048, (const float*)(ws + AR_PART), (ssq_t*)(ws + WS_H + HB_STRIDE), nullptr, HB, (bf16_t*)(ws + WS_H)); } }
            if (L == 0 && REPEAT == 28) { for (int r_ = 0; r_ < 16; ++r_) { xcd_barrier(bar, wv); } } PHASE_END
        PHASE_BEGIN(true) {
            pg8::Gemm g{HB, (const bf16_t*)(ws + WS_WFUP) + (size_t)L * DFF2 * 2048, MT, DFF2, 2048};
            pg8::StaticOrder S; S.init(MT, DFF2, 2048, G, wg, false);
            EpiGlu E{SSV(3 * L + 1), (bf16_t*)(ws + AR_ACT), (float*)(ws + AR_XB), P.in[I_WFCONV] + (size_t)L * 3 * DFF2, P.in[I_BFCONV] + (size_t)L * DFF2, P.out + O_PF + (size_t)L * NBP * 2 * DFF2, P.out + O_SF + (size_t)L * NBS * 2 * DFF2};
            pg8::gemm_phase(lds, g, S, E, wv);
            if (L == 0) REP(5, pg8::gemm_phase(lds, g, S, E, wv));
            if (L == 0) REP(15, pg8::gemm_phase(lds, g, S, EpiNull{}, wv));
#define RX_(...) { xcd_barrier(bar, wv); pg8::gemm_phase(lds, g, S, E, wv); __VA_ARGS__; }
            if (L == 0 && REPEAT == 23) { RX_() RX_() RX_() RX_() }
            if (L == 0 && REPEAT == 24) { RX_(prep_fill<2>(P, wv, lds, S.nwg, launder_s(G), launder_s(wg))) RX_(prep_fill<2>(P, wv, lds, S.nwg, launder_s(G), launder_s(wg))) RX_(prep_fill<2>(P, wv, lds, S.nwg, launder_s(G), launder_s(wg))) RX_(prep_fill<2>(P, wv, lds, S.nwg, launder_s(G), launder_s(wg))) }
#undef RX_
            { const int G2 = launder_s(G), wg2 = launder_s(wg);
              if (L == 0) prep_fill<2>(P, wv, lds, S.nwg, G2, wg2); else if (L == 1) prep_fill<4>(P, wv, lds, S.nwg, G2, wg2); else if (L == 2) prep_fill<6>(P, wv, lds, S.nwg, G2, wg2); else prep_fill<8>(P, wv, lds, S.nwg, G2, wg2); }
        } PHASE_END
        PHASE_BEGIN(true) phase_ef(P, wv, L); if (L == 0) REP(6, phase_ef(P, wv, L)); PHASE_END
        PHASE_BEGIN(true) {
            { pg8::Gemm g{(const bf16_t*)(ws + AR_ACT), (const bf16_t*)(ws + WS_WFDOWN) + (size_t)L * 2048 * DFF, MT, 2048, DFF};
              pg8::StaticOrder S; S.init(MT, 2048, DFF, G, wg, TAILK);
              EpiResid<false> E{H, HB, HB, SSV(3 * L + 2), nullptr, nullptr};
              pg8::gemm_phase(lds, g, S, E, wv, (float*)(ws + AR_PART)); }
            { unsigned char* ws2 = ws; asm volatile("" : "+s"(ws2)); const int G2 = launder_s(G), wg2 = launder_s(wg);
              pg8::Gemm g{(const bf16_t*)(ws2 + WS_PB) + (size_t)L * MT * PLE, (const bf16_t*)(ws2 + WS_WPP) + (size_t)L * 2048 * PLE, MT, 2048, launder_s(PLE)};
              pg8::StaticOrder S; S.init(MT, 2048, PLE, G2, G2 - 1 - wg2, false);
              EpiPlain E{(bf16_t*)(ws2 + AR_PPB), DM};
              pg8::gemm_phase(lds, g, S, E, wv); }
#define RXF_ { xcd_barrier(bar, wv); \
              { pg8::Gemm g{(const bf16_t*)(ws + AR_ACT), (const bf16_t*)(ws + WS_WFDOWN), MT, 2048, DFF}; \
                pg8::StaticOrder S; S.init(MT, 2048, DFF, launder_s(G), launder_s(wg), TAILK); \
                EpiResid<false> E{H, HB, (bf16_t*)(ws + WS_H), (ssq_t*)(ws + WS_H + HB_STRIDE), nullptr, nullptr}; \
                pg8::gemm_phase(lds, g, S, E, wv, (float*)(ws + AR_PART)); } \
              { const int G2 = launder_s(G), wg2 = launder_s(wg); \
                pg8::Gemm g{(const bf16_t*)(ws + WS_PB), (const bf16_t*)(ws + WS_WPP), MT, 2048, launder_s(PLE)}; \
                pg8::StaticOrder S; S.init(MT, 2048, PLE, G2, G2 - 1 - wg2, false); \
                EpiPlain E{(bf16_t*)(ws + AR_PPB), DM}; \
                pg8::gemm_phase(lds, g, S, E, wv); } }
            if (L == 0 && REPEAT == 47) { RXF_ RXF_ }
#define RXP_ { xcd_barrier(bar, wv); { const int G2 = launder_s(G), wg2 = launder_s(wg); \
                pg8::Gemm g{(const bf16_t*)(ws + WS_PB), (const bf16_t*)(ws + WS_WPP), MT, 2048, launder_s(PLE)}; \
                pg8::StaticOrder S; S.init(MT, 2048, PLE, G2, G2 - 1 - wg2, false); \
                EpiPlain E{(bf16_t*)(ws + AR_PPB), DM}; \
                pg8::gemm_phase(lds, g, S, E, wv); } }
            if (L == 0 && REPEAT == 49) { RXP_ RXP_ RXP_ RXP_ }
#undef RXP_
#undef RXF_
        } PHASE_END
        PHASE_BEGIN(TAILK) phase_reduce(P, wv, DFF, (const float*)(ws + AR_PART), SSV(3 * L + 2), nullptr, HB, HB); PHASE_END
        PHASE_BEGIN(true) {
            pg8::Gemm g{HB, (const bf16_t*)(ws + WS_WPG) + (size_t)L * 2048 * 2048, MT, 2048, 2048};
            pg8::StaticOrder S; S.init(MT, 2048, 2048, G, wg, TAILK);
            EpiResid<true> E{H, HB, HBN, SSV(3 * L + 3), SSV(3 * L + 2), (const bf16_t*)(ws + AR_PPB)};
            pg8::gemm_phase(lds, g, S, E, wv, (float*)(ws + AR_PART));
        } PHASE_END
        PHASE_BEGIN(TAILK) phase_reduce(P, wv, 2048, (const float*)(ws + AR_PART), SSV(3 * L + 3), SSV(3 * L + 2), HB, HBN); PHASE_END
    }
    hbsel = 4;
    PHASE_BEGIN(true) phase_final(P, wv, HB); REP(7, phase_final(P, wv, HB)); PHASE_END
#undef PHASE_BEGIN
#undef PHASE_END
#ifdef TS_A
    xcd_barrier(bar, wv); TS_CAP(NPH);
    if (launder_s((int)blockIdx.x) == 0 && fresh_tid(wv) == 0) { volatile unsigned long long* tsp = (volatile unsigned long long*)(P0.ws + WS_CTL + 32768); const float us = (float)(long long)(tsp[1] - tsp[0]) * 0.01f; P0.out[0] = floorf(us / (float)TS_SCALE + 0.5f) * 1.0e9f; }
#endif
}
extern "C" void kernel_launch(void* const* d_in, const int* in_sizes, int n_in, void* d_out, int out_size, void* d_ws, size_t ws_size, hipStream_t stream) {
    static int grid = 0;
    if (grid == 0) {
        if (n_in != N_IN || out_size != (int)O_END || ws_size < WS_NEED) { fprintf(stderr, "kernel_launch: unexpected problem: n_in %d out %d ws %zu (need %zu)\n", n_in, out_size, ws_size, (size_t)WS_NEED); grid = -1; return; }
        int dev = 0, cus = 0;
        if (hipGetDevice(&dev) != hipSuccess || hipDeviceGetAttribute(&cus, hipDeviceAttributeMultiprocessorCount, dev) != hipSuccess) { grid = -1; return; }
        if (hipFuncSetAttribute((const void*)mega, hipFuncAttributeMaxDynamicSharedMemorySize, LDS_BYTES) != hipSuccess) { fprintf(stderr, "kernel_launch: hipFuncSetAttribute failed\n"); grid = -1; return; }
        int per_cu = 0;
        if (hipOccupancyMaxActiveBlocksPerMultiprocessor(&per_cu, (const void*)mega, NTH, LDS_BYTES) != hipSuccess || per_cu < 1) { fprintf(stderr, "kernel_launch: occupancy query says %d\n", per_cu); grid = -1; return; }
        grid = cus;
    }
    if (grid <= 0) return;
    (void)hipMemsetAsync((char*)d_ws + WS_CTL, 0, CTL_BYTES, stream);
    Params p{};
    for (int i = 0; i < N_IN; ++i) p.in[i] = (const float*)d_in[i];
    p.out = (float*)d_out; p.ws = (unsigned char*)d_ws;
#ifndef DBG
    p.pb = 0; p.pe = NPH;
    hipLaunchKernelGGL(mega, dim3(grid), dim3(NTH), LDS_BYTES, stream, p);
#else
    dbg_run(p, grid, stream);
#endif
}
```

```cpp
#include <hip/hip_runtime.h>
#include <cstdio>
#include <cstdint>

#define LAS __attribute__((address_space(3)))
typedef unsigned short bf16_t;
typedef short bf16x8 __attribute__((ext_vector_type(8)));
typedef float f32x4 __attribute__((ext_vector_type(4)));
typedef float f32x2 __attribute__((ext_vector_type(2)));
typedef unsigned u32x4 __attribute__((ext_vector_type(4)));
typedef unsigned u32x2 __attribute__((ext_vector_type(2)));

constexpr int DM = 2048, SEQ = 4096, DSEQ = 64, NBP = 4, NBS = 16;
constexpr int MP = NBP * SEQ, MS = NBS * DSEQ, MT = MP + MS;
constexpr int DFF = 5632, DFF2 = 11264, PLE = 256;
constexpr int DNC = 8192, DNV = 4096, DNIN = 12352;
constexpr int NTH = 512;
constexpr float EPS = 1e-6f;

enum { I_XP = 0, I_XS, I_STA, I_STBC, I_STBS, I_CK, I_CV, I_STF, I_PP, I_PS, I_GMIX, I_GFFN, I_WAIN, I_WACONV, I_WAOUT, I_WBIN, I_WBCONV, I_ALOG, I_DTB, I_GBOUT, I_WBOUT,
       I_WCQKV, I_GCQ, I_GCK, I_RELB, I_WCOUT, I_WFUP, I_WFCONV, I_BFCONV, I_WFDOWN, I_GPLE, I_WPG, I_WPP, I_GFIN, N_IN };

constexpr size_t O_YP = 0, O_YS = O_YP + (size_t)MP * DM, O_PA = O_YS + (size_t)MS * DM, O_PBC = O_PA + 2 * 4 * 2 * 2048, O_PBS = O_PBC + 4 * 3 * 8192,
                 O_PCK = O_PBS + (size_t)4 * 32 * 128 * 128, O_PCV = O_PCK + (size_t)4 * 512 * 2048, O_PF = O_PCV + (size_t)4 * 512 * 2048, O_SA = O_PF + 4 * 4 * 2 * 11264,
                 O_SBC = O_SA + 2 * 16 * 2 * 2048, O_SBS = O_SBC + 16 * 3 * 8192, O_SCK = O_SBS + (size_t)16 * 32 * 128 * 128, O_SCV = O_SCK + (size_t)16 * 64 * 2048,
                 O_SF = O_SCV + (size_t)16 * 64 * 2048, O_END = O_SF + 4 * 16 * 2 * 11264;
static_assert(O_END == 61177856, "output size");

constexpr size_t al256(size_t x) { return (x + 255) & ~(size_t)255; }
constexpr size_t WS_CTL = 0;
constexpr size_t CTL_BYTES = 65536;
constexpr size_t WS_SS = WS_CTL + CTL_BYTES;
constexpr int NSS = 13;
constexpr size_t SS_BYTES = al256((size_t)NSS * MT * 8);
constexpr size_t ZERO_BYTES = CTL_BYTES + SS_BYTES;
constexpr size_t WS_BA = WS_SS + SS_BYTES;
constexpr size_t WS_WAIN = WS_BA + (size_t)MT * 64 * 4;
constexpr size_t WS_WAOUT = WS_WAIN + (size_t)2 * 6144 * 2048 * 2;
constexpr size_t WS_WBIN = WS_WAOUT + (size_t)2 * 2048 * 2048 * 2;
constexpr size_t WS_WBBA = WS_WBIN + (size_t)12288 * 2048 * 2;
constexpr size_t WS_WBOUT = WS_WBBA + (size_t)64 * 2048 * 2;
constexpr size_t WS_WCQKV = WS_WBOUT + (size_t)2048 * 4096 * 2;
constexpr size_t WS_WCOUT = WS_WCQKV + (size_t)6144 * 2048 * 2;
constexpr size_t WS_WFUP = WS_WCOUT + (size_t)2048 * 2048 * 2;
constexpr size_t WS_WFDOWN = WS_WFUP + (size_t)4 * 11264 * 2048 * 2;
constexpr size_t WS_WPG = WS_WFDOWN + (size_t)4 * 2048 * 5632 * 2;
constexpr size_t WS_WPP = WS_WPG + (size_t)4 * 2048 * 2048 * 2;
constexpr size_t WS_H = WS_WPP + (size_t)4 * 2048 * 256 * 2;
constexpr size_t WS_HB = WS_H + (size_t)MT * DM * 4;
constexpr size_t HB_STRIDE = (size_t)MT * DM * 2;
constexpr size_t WS_PB = WS_HB + 2 * HB_STRIDE;
constexpr size_t WS_ARENA = WS_PB + (size_t)4 * MT * PLE * 2;
constexpr size_t AR_BG = WS_ARENA, AR_CV = AR_BG + (size_t)MT * DM * 2, AR_AA = AR_CV + (size_t)MT * DM * 2, AR_A_END = AR_AA + (size_t)MT * DM * 2;
constexpr size_t AR_QKVP = WS_ARENA, AR_Z = AR_QKVP + (size_t)MT * DNC * 2, AR_ODR = AR_Z + (size_t)MT * DNV * 2, AR_HALO = AR_ODR + (size_t)MT * DNV * 2, AR_B_END = AR_HALO + (size_t)(MT / 64) * 3 * 4096 * 2;
constexpr size_t AR_QKV = WS_ARENA, AR_VTP = AR_QKV + (size_t)MT * 6144 * 2, AR_VTS = AR_VTP + (size_t)4 * 16 * 128 * 4096 * 2, AR_KS = AR_VTS + (size_t)16 * 16 * 128 * 576 * 2,
                 AR_OATT = AR_KS + (size_t)16 * 576 * 2048 * 2, AR_C_END = AR_OATT + (size_t)MT * DM * 2;
constexpr size_t AR_ACT = WS_ARENA, AR_XB = AR_ACT + (size_t)MT * DFF * 2, AR_PPB = AR_XB + (size_t)(MT / 64) * 4 * DFF2 * 4, AR_F_END = AR_PPB + (size_t)MT * DM * 2;
constexpr size_t AR_PART = WS_ARENA + ((size_t)400 << 20), AR_PART_B = WS_ARENA, PART_BYTES = (size_t)256 * 65536 * 4;
constexpr size_t WS_END = AR_B_END > AR_F_END ? (AR_B_END > AR_C_END ? AR_B_END : AR_C_END) : (AR_F_END > AR_C_END ? AR_F_END : AR_C_END);
static_assert(AR_A_END <= WS_END && AR_B_END <= WS_END && AR_C_END <= WS_END && AR_F_END <= WS_END, "arena");
static_assert(AR_A_END <= AR_PART && AR_F_END <= AR_PART && AR_PART + PART_BYTES <= WS_END && AR_PART_B + PART_BYTES <= AR_ODR && AR_PART_B + PART_BYTES <= AR_VTP, "partials");
#ifdef DBG
constexpr size_t WS_HCOPY = WS_END;
constexpr size_t WS_NEED = WS_HCOPY + HB_STRIDE;
#else
constexpr size_t WS_NEED = WS_END;
#endif

struct Params { const float* in[N_IN]; float* out; unsigned char* ws; int pb, pe; };

__device__ __forceinline__ int launder_v(int v) { asm volatile("" : "+v"(v)); return v; }
__device__ __forceinline__ int launder_s(int v) { asm volatile("" : "+s"(v)); return v; }
__device__ __forceinline__ int fresh_tid(int wv) { unsigned z = 0u; asm volatile("" : "+v"(z));
    int t = wv * 64 + (int)__builtin_amdgcn_mbcnt_hi(~0u, __builtin_amdgcn_mbcnt_lo(~0u, z)); asm volatile("" : "+v"(t)); return t; }
__device__ __forceinline__ const Params& fresh(const Params& P) { const Params* p = &P; asm volatile("" : "+s"(p)); return *p; }
__device__ __forceinline__ float bf2f(bf16_t v) { return __uint_as_float(((unsigned)v) << 16); }
__device__ __forceinline__ float bflo(unsigned w) { return __uint_as_float(w << 16); }
__device__ __forceinline__ float bfhi(unsigned w) { return __uint_as_float(w & 0xffff0000u); }
typedef __bf16 bf16x2_t __attribute__((ext_vector_type(2)));
__device__ __forceinline__ unsigned cvt_pk_bf16(float lo, float hi) { const bf16x2_t v = __builtin_convertvector((f32x2){lo, hi}, bf16x2_t); unsigned r; __builtin_memcpy(&r, &v, 4); return r; }
__device__ __forceinline__ bf16_t f2bf(float f) { return (bf16_t)(cvt_pk_bf16(f, 0.f) & 0xffffu); }
__device__ __forceinline__ float sigmoidf_(float x) { return __builtin_amdgcn_rcpf(1.0f + __expf(-x)); }
__device__ __forceinline__ float siluf_(float x) { return x * __builtin_amdgcn_rcpf(1.0f + __expf(-x)); }
#define DPPF(old, v, ctrl, rm) __int_as_float(__builtin_amdgcn_update_dpp(__float_as_int(old), __float_as_int(v), (ctrl), (rm), 0xf, false))
__device__ __forceinline__ float wave_sum(float v) {
    v += DPPF(0.f, v, 0xB1, 0xf);
    v += DPPF(0.f, v, 0x4E, 0xf);
    v += DPPF(0.f, v, 0x141, 0xf);
    v += DPPF(0.f, v, 0x140, 0xf);
    v += DPPF(0.f, v, 0x142, 0xa);
    v += DPPF(0.f, v, 0x143, 0xc);
    return __int_as_float(__builtin_amdgcn_readlane(__float_as_int(v), 63));
}
typedef unsigned long long ssq_t;
constexpr float SSQ_SCALE = 16777216.0f;
__device__ __forceinline__ ssq_t ssq_fix(float sq) { return (ssq_t)(sq * SSQ_SCALE + 0.5f); }
#ifndef WT_AUX
#define WT_AUX 2
#endif
__device__ __forceinline__ float rstd_of(const ssq_t* ss, int row) { return rsqrtf((float)ss[row] * (1.0f / (2048.0f * SSQ_SCALE)) + EPS); }
__device__ __forceinline__ void row_pos(int row, int& b, int& s, int& S) { if (row < MP) { b = row >> 12; s = row & 4095; S = SEQ; } else { const int rr = row - MP; b = rr >> 6; s = rr & 63; S = DSEQ; } }

#define XB_TMO      128
#define XB_XCNT(j)  (256  + 64 * (j))
#define XB_XSUB(j)  (1280 + 64 * (j))
#define XB_XGEN(j)  (2304 + 64 * (j))
#define XB_TOP      3328
#define XB_TOPGEN   3392
#define XCD_BAR_WORDS 3456
#define XB_SPIN_CAP (1u << 18)
__device__ __forceinline__ unsigned xb_ld(unsigned* p)              { return __hip_atomic_load(p, __ATOMIC_RELAXED, __HIP_MEMORY_SCOPE_AGENT); }
__device__ __forceinline__ unsigned xb_add(unsigned* p, unsigned v) { return __hip_atomic_fetch_add(p, v, __ATOMIC_RELAXED, __HIP_MEMORY_SCOPE_AGENT); }
__device__ __forceinline__ unsigned xb_xcc_id() { return (unsigned)__builtin_amdgcn_s_getreg((3 << 11) | 20) & 0xFu; }
#define XB_SPIN(cond, bar) do { unsigned _sp = 0; while (cond) { __builtin_amdgcn_s_sleep(1); \
    if ((++_sp & 255u) == 0u) { if (xb_ld(&(bar)[XB_TMO])) break; if (_sp > XB_SPIN_CAP) { atomicAdd(&(bar)[XB_TMO], 1u); break; } } } } while (0)
struct XcdBarrier { unsigned* bar; unsigned x; volatile LAS unsigned* st; };
__device__ __forceinline__ XcdBarrier xcd_barrier_post(unsigned* bar, volatile LAS unsigned* st) {
    XcdBarrier b; b.bar = bar; b.x = xb_xcc_id(); b.st = st;
    if (threadIdx.x == 0) (void)xb_add(&bar[XB_XCNT(b.x)], 1u);
    return b;
}
__device__ __forceinline__ void xcd_barrier_complete(unsigned* bar, unsigned x, unsigned& nloc, unsigned& nx) {
    const unsigned G = gridDim.x * gridDim.y * gridDim.z;
    unsigned sum, cnt, mine, sp = 0u;
    for (;;) {
        sum = 0u; cnt = 0u; mine = 0u;
#pragma unroll
        for (unsigned j = 0; j < 16; ++j) { const unsigned c = xb_ld(&bar[XB_XCNT(j)]); sum += c; cnt += (c > 0u) ? 1u : 0u; mine = (j == x) ? c : mine; }
        if (sum == G) break;
        __builtin_amdgcn_s_sleep(1);
        if ((++sp & 255u) == 0u) { if (xb_ld(&bar[XB_TMO])) break; if (sp > XB_SPIN_CAP) { atomicAdd(&bar[XB_TMO], 1u); break; } }
    }
    nloc = mine > 0u ? mine : 1u; nx = cnt > 0u ? cnt : 1u;
}
__device__ __forceinline__ void xcd_barrier(const XcdBarrier& b, int wv) {
    asm volatile("s_waitcnt vmcnt(0)" ::: "memory");
    __syncthreads();
    if (fresh_tid(wv) == 0) {
        unsigned* bar = b.bar;
        __builtin_amdgcn_s_waitcnt(0);
        unsigned nloc = b.st[0], nx = b.st[1];
        if (nloc == 0u) { xcd_barrier_complete(bar, b.x, nloc, nx); b.st[0] = nloc; b.st[1] = nx; }
        const unsigned old = xb_add(&bar[XB_XSUB(b.x)], 1u);
        const unsigned gen = old / nloc;
        if (old + 1u == (gen + 1u) * nloc) {
            __builtin_amdgcn_fence(__ATOMIC_RELEASE, "agent");
            asm volatile("s_waitcnt vmcnt(0)" ::: "memory");
            const unsigned og = xb_add(&bar[XB_TOP], 1u);
            const unsigned tg = og / nx;
            if (og + 1u == (tg + 1u) * nx) xb_add(&bar[XB_TOPGEN], 1u);
            else XB_SPIN(xb_ld(&bar[XB_TOPGEN]) == tg, bar);
            __builtin_amdgcn_fence(__ATOMIC_ACQUIRE, "agent");
            xb_add(&bar[XB_XGEN(b.x)], 1u);
            asm volatile("s_waitcnt vmcnt(0)" ::: "memory");
        } else {
            XB_SPIN(xb_ld(&bar[XB_XGEN(b.x)]) == gen, bar);
            __builtin_amdgcn_fence(__ATOMIC_ACQUIRE, "agent");
            asm volatile("s_waitcnt vmcnt(0)" ::: "memory");
        }
    }
    __syncthreads();
}
namespace pg8 {
constexpr int BM = 256, BK = 64, HALF = 128, HTB = HALF * BK * 2, STAGE_BYTES = 8 * HTB, NXCD = 8, WGM = 8;
__host__ __device__ __forceinline__ int lds_byte(int r, int c) { const int st = (r >> 4) * 2 + (c >> 5), rr = r & 15, cc = c & 31, ob = rr * 64 + cc * 2; return st * 1024 + (ob ^ (((ob >> 9) & 1) << 5)); }
__host__ __device__ __forceinline__ void stage_rc(int b, int& R, int& C) { const int st = b / 1024, sb = b % 1024, swz = sb ^ (((sb >> 9) & 1) << 5); R = (st >> 1) * 16 + swz / 64; C = (st & 1) * 32 + (swz % 64) / 2; }
__host__ __device__ __forceinline__ int perm32(int rho) { const int n = rho >> 4, i = rho & 15; return 8 * (i >> 2) + 4 * n + (i & 3); }
struct Unit { int pm, pn, k0, nt, part; };
struct Gemm { const bf16_t* A; const bf16_t* Bt; int M, N, K; int amul = 1, bmul = 1; };
struct StaticOrder {
    int nM, nN, nwg, G, c, KT, nreg;
    __device__ __forceinline__ void init(int M, int N, int K, int G_, int c_, bool tail) { nM = M / BM; nN = N / BM; nwg = nM * nN; G = G_; c = c_; KT = K / BK; nreg = nwg;
        if (tail) { const int rem = nwg % G; if (rem > 0 && rem * 8 == G && (KT / 8) >= 4) nreg = nwg - rem; } }
    __device__ __forceinline__ int map(int L) const {
        int wgid = L; { const int q = nwg / NXCD, r = nwg % NXCD, xcd = wgid % NXCD, off = wgid / NXCD; wgid = (xcd < r ? xcd * (q + 1) : r * (q + 1) + (xcd - r) * q) + off; }
        const int nig = WGM * nN, gid = wgid / nig, fm = gid * WGM, gsz = (nM - fm) < WGM ? (nM - fm) : WGM;
        return ((fm + ((wgid % nig) % gsz)) << 16) | ((wgid % nig) / gsz);
    }
    __device__ __forceinline__ bool next(int i, Unit& u) const {
        const bool ht = nreg < nwg, tl = ht && i == 0;
        const long L = (long)(ht ? i - 1 : i) * G + c;
        const bool reg = !tl && L < nreg;
        const int j = c >> 3, s = c & 7, q = KT >> 3;
        const int pq = map(reg ? (int)L : (tl ? nreg + j : 0));
        const int nt_t = (q & 1) ? ((s & 1) ? q - 1 : q + 1) : q, k0_t = ((q & 1) ? (s * q + (s & 1)) : s * q) * BK;
        u.pm = pq >> 16; u.pn = pq & 0xffff; u.k0 = reg ? 0 : k0_t; u.nt = reg ? KT : nt_t; u.part = reg ? -1 : j * 8 + s;
        return reg || tl;
    }
};
template <class Epi>
__device__ __forceinline__ void gemm_phase(LAS unsigned char* lds, const Gemm g, const StaticOrder& S, const Epi& E, int wv, float* PART = nullptr) {
    const int tid = fresh_tid(wv), wid = __builtin_amdgcn_readfirstlane(tid >> 6), lane = tid & 63, wr = wid >> 2, wc = wid & 3, fr = lane & 15, fq = lane >> 4;
    const int K = g.K;
    unsigned voffA[2], voffB[2];
#pragma unroll
    for (int i = 0; i < 2; ++i) { int R, C; stage_rc(tid * 16 + i * 8192, R, C); const int Rb = ((R & ~31) + perm32(R & 31));
        voffA[i] = (unsigned)(R * K + C) * 2u; voffB[i] = (unsigned)(Rb * K + C) * 2u; }
    const size_t kstep = (size_t)(BK * 2);
    const size_t hstep = (size_t)HALF * K * 2;
    const size_t tstep = 2 * hstep;
    const unsigned ldsw = (unsigned)wid * 1024u;
    const int aoff = lds_byte(wr * 64 + fr, fq * 8), boff = lds_byte(wc * 32 + fr, fq * 8);
#define PG8_SA(b, h) (((b) * 2 + (h)) * HTB)
#define PG8_SB(b, h) ((4 + (b) * 2 + (h)) * HTB)
#define PG8_STAGE(bufoff, gbase, voff) do { _Pragma("unroll") for (int _i = 0; _i < 2; ++_i) \
        __builtin_amdgcn_global_load_lds((const unsigned*)((const char*)(gbase) + (voff)[_i]), (LAS unsigned*)(lds + (bufoff) + ldsw + _i * 8192), 16, 0, 0); } while (0)
#define PG8_LDA(dst, b, h) do { _Pragma("unroll") for (int m = 0; m < 4; ++m) _Pragma("unroll") for (int k = 0; k < 2; ++k) dst[m][k] = *(const LAS bf16x8*)(lds + PG8_SA(b, h) + aoff + m * 2048 + k * 1024); } while (0)
#define PG8_LDB(dst, b, h) do { _Pragma("unroll") for (int n = 0; n < 2; ++n) _Pragma("unroll") for (int k = 0; k < 2; ++k) dst[n][k] = *(const LAS bf16x8*)(lds + PG8_SB(b, h) + boff + n * 2048 + k * 1024); } while (0)
#define PG8_MMA(ai, bj, At, Bt) do { __builtin_amdgcn_s_setprio(1); _Pragma("unroll") for (int m = 0; m < 4; ++m) _Pragma("unroll") for (int n = 0; n < 2; ++n) _Pragma("unroll") for (int k = 0; k < 2; ++k) \
        acc[ai][bj][m][n] = __builtin_amdgcn_mfma_f32_16x16x32_bf16(Bt[n][k], At[m][k], acc[ai][bj][m][n], 0, 0, 0); __builtin_amdgcn_s_setprio(0); } while (0)
#define PG8_WAIT_V(n) asm volatile("s_waitcnt vmcnt(" #n ")" ::: "memory")
#define PG8_WAIT_L(n) asm volatile("s_waitcnt lgkmcnt(" #n ")" ::: "memory")
#define PG8_BAR __builtin_amdgcn_s_barrier()
#define PG8_SCHED __builtin_amdgcn_sched_barrier(0)
    Unit cur, nxt; int ui = 0;
    if (!S.next(0, cur)) return;
    f32x4 acc[2][2][4][2];
#pragma unroll
    for (int a = 0; a < 2; ++a)
#pragma unroll
        for (int b = 0; b < 2; ++b)
#pragma unroll
            for (int m = 0; m < 4; ++m)
#pragma unroll
                for (int n = 0; n < 2; ++n) acc[a][b][m][n] = (f32x4){0.f, 0.f, 0.f, 0.f};
    bf16x8 At[4][2], B0[2][2], B1[2][2];
    const char* cA = (const char*)g.A + (size_t)(cur.pm * g.amul) * tstep + (size_t)cur.k0 * 2; const char* cB = (const char*)g.Bt + (size_t)(cur.pn * g.bmul) * tstep + (size_t)cur.k0 * 2;
    int nt = cur.nt;
#ifdef PG8_OLD
    PG8_STAGE(PG8_SB(0, 0), cB, voffB); PG8_STAGE(PG8_SA(0, 0), cA, voffA); PG8_STAGE(PG8_SB(0, 1), cB + hstep, voffB); PG8_STAGE(PG8_SA(0, 1), cA + hstep, voffA);
    if (wr == 1) PG8_BAR;
    PG8_WAIT_V(4); PG8_BAR;
    PG8_STAGE(PG8_SB(1, 0), cB + kstep, voffB); PG8_STAGE(PG8_SA(1, 0), cA + kstep, voffA); PG8_STAGE(PG8_SB(1, 1), cB + hstep + kstep, voffB);
    PG8_WAIT_V(6); PG8_BAR;
#else
    PG8_STAGE(PG8_SB(0, 0), cB, voffB); PG8_STAGE(PG8_SB(0, 1), cB + hstep, voffB); PG8_STAGE(PG8_SA(0, 0), cA, voffA); PG8_STAGE(PG8_SA(0, 1), cA + hstep, voffA);
    if (wr == 1) PG8_BAR;
    PG8_WAIT_V(2); PG8_BAR;
    PG8_STAGE(PG8_SB(1, 0), cB + kstep, voffB); PG8_STAGE(PG8_SA(1, 0), cA + kstep, voffA); PG8_STAGE(PG8_SB(1, 1), cB + hstep + kstep, voffB);
    PG8_WAIT_V(6); PG8_BAR;
#endif
    for (;;) {
        const bool has_next = S.next(ui + 1, nxt);
        const char* nA = has_next ? (const char*)g.A + (size_t)(nxt.pm * g.amul) * tstep + (size_t)nxt.k0 * 2 : cA; const char* nB = has_next ? (const char*)g.Bt + (size_t)(nxt.pn * g.bmul) * tstep + (size_t)nxt.k0 * 2 : cB;
        for (int t = 0; t < nt; t += 2) {
            const bool last = (t == nt - 2);
            const char* a1 = cA + (size_t)(t + 1) * kstep;
            const char* a2 = last ? nA : cA + (size_t)(t + 2) * kstep; const char* b2 = last ? nB : cB + (size_t)(t + 2) * kstep;
            const char* a3 = a2 + kstep; const char* b3 = b2 + kstep;
#ifdef PG8_OLD
            PG8_LDB(B0, 0, 0); PG8_SCHED; PG8_LDA(At, 0, 0); PG8_STAGE(PG8_SA(1, 1), a1 + hstep, voffA);
            PG8_WAIT_L(8); PG8_BAR; PG8_WAIT_L(0); PG8_MMA(0, 0, At, B0); PG8_BAR; PG8_SCHED;
            PG8_LDB(B1, 0, 1); PG8_STAGE(PG8_SB(0, 0), b2, voffB);
            PG8_BAR; PG8_WAIT_L(0); PG8_MMA(0, 1, At, B1); PG8_BAR;
            PG8_LDA(At, 0, 1); PG8_STAGE(PG8_SA(0, 0), a2, voffA);
            PG8_BAR; PG8_WAIT_L(0); PG8_MMA(1, 0, At, B0); PG8_BAR; PG8_SCHED;
            PG8_STAGE(PG8_SB(0, 1), b2 + hstep, voffB);
            PG8_WAIT_V(6); PG8_BAR; PG8_MMA(1, 1, At, B1); PG8_BAR;
            PG8_LDB(B0, 1, 0); PG8_SCHED; PG8_LDA(At, 1, 0); PG8_STAGE(PG8_SA(0, 1), a2 + hstep, voffA);
            PG8_WAIT_L(8); PG8_BAR; PG8_WAIT_L(0); PG8_MMA(0, 0, At, B0); PG8_BAR; PG8_SCHED;
            PG8_LDB(B1, 1, 1); PG8_STAGE(PG8_SB(1, 0), b3, voffB);
            PG8_BAR; PG8_WAIT_L(0); PG8_MMA(0, 1, At, B1); PG8_BAR;
            PG8_LDA(At, 1, 1); PG8_STAGE(PG8_SA(1, 0), a3, voffA);
            PG8_BAR; PG8_WAIT_L(0); PG8_MMA(1, 0, At, B0); PG8_BAR; PG8_SCHED;
            PG8_STAGE(PG8_SB(1, 1), b3 + hstep, voffB);
            PG8_WAIT_V(6); PG8_BAR; PG8_MMA(1, 1, At, B1); PG8_BAR;
#else
            PG8_LDB(B0, 0, 0); PG8_LDB(B1, 0, 1); PG8_SCHED; PG8_LDA(At, 0, 0); PG8_STAGE(PG8_SA(1, 1), a1 + hstep, voffA);
            PG8_WAIT_V(8);
            PG8_WAIT_L(0); PG8_BAR; PG8_MMA(0, 0, At, B0); PG8_MMA(0, 1, At, B1); PG8_BAR; PG8_SCHED;
            PG8_LDA(At, 0, 1); PG8_STAGE(PG8_SB(0, 0), b2, voffB); PG8_STAGE(PG8_SB(0, 1), b2 + hstep, voffB); PG8_STAGE(PG8_SA(0, 0), a2, voffA);
            PG8_WAIT_V(8);
            PG8_WAIT_L(0); PG8_BAR; PG8_MMA(1, 0, At, B0); PG8_MMA(1, 1, At, B1); PG8_BAR; PG8_SCHED;
            PG8_LDB(B0, 1, 0); PG8_LDB(B1, 1, 1); PG8_SCHED; PG8_LDA(At, 1, 0); PG8_STAGE(PG8_SA(0, 1), a2 + hstep, voffA);
            PG8_WAIT_V(8); PG8_WAIT_L(0); PG8_BAR; PG8_MMA(0, 0, At, B0); PG8_MMA(0, 1, At, B1); PG8_BAR; PG8_SCHED;
            PG8_LDA(At, 1, 1); PG8_STAGE(PG8_SB(1, 0), b3, voffB); PG8_STAGE(PG8_SB(1, 1), b3 + hstep, voffB); PG8_STAGE(PG8_SA(1, 0), a3, voffA);
            PG8_WAIT_V(8); PG8_WAIT_L(0); PG8_BAR; PG8_MMA(1, 0, At, B0); PG8_MMA(1, 1, At, B1); PG8_BAR; PG8_SCHED;
#endif
        }
#ifndef PG8_OLD
        if (wr == 0) PG8_BAR;
#endif
        if (cur.part >= 0) {
            bf16_t* pt = (bf16_t*)PART + (size_t)cur.part * 65536 + (size_t)(wr * 64 + fr) * 256 + wc * 32 + 8 * fq;
#pragma unroll
            for (int ai = 0; ai < 2; ++ai)
#pragma unroll
                for (int m = 0; m < 4; ++m)
#pragma unroll
                    for (int bj = 0; bj < 2; ++bj) { bf16_t* q = pt + (size_t)(ai * 128 + m * 16) * 256 + bj * 128; const f32x4 a_ = acc[ai][bj][m][0], b_ = acc[ai][bj][m][1]; u32x4 w_; w_.x = cvt_pk_bf16(a_[0], a_[1]); w_.y = cvt_pk_bf16(a_[2], a_[3]); w_.z = cvt_pk_bf16(b_[0], b_[1]); w_.w = cvt_pk_bf16(b_[2], b_[3]); *(u32x4*)q = w_; }
        } else E(acc, cur, wr, wc, fr, fq);
        if (!has_next) break;
#pragma unroll
        for (int a = 0; a < 2; ++a)
#pragma unroll
            for (int b = 0; b < 2; ++b)
#pragma unroll
                for (int m = 0; m < 4; ++m)
#pragma unroll
                    for (int n = 0; n < 2; ++n) acc[a][b][m][n] = (f32x4){0.f, 0.f, 0.f, 0.f};
        cur = nxt; cA = nA; cB = nB; nt = cur.nt; ++ui;
#ifndef PG8_OLD
        if (wr == 1) PG8_BAR;
#endif
    }
    PG8_WAIT_V(0);
#ifdef PG8_OLD
    if (wr == 0) PG8_BAR;
#endif
    PG8_BAR;
#undef PG8_SA
#undef PG8_SB
#undef PG8_STAGE
#undef PG8_LDA
#undef PG8_LDB
#undef PG8_MMA
#undef PG8_WAIT_V
#undef PG8_WAIT_L
#undef PG8_BAR
#undef PG8_SCHED
}
}
using pg8::Unit;

typedef f32x4 Acc[2][2][4][2];
#define EPI_ROWS(...) _Pragma("unroll") for (int ai = 0; ai < 2; ++ai) _Pragma("unroll") for (int m = 0; m < 4; ++m) { const int row = u.pm * 256 + ai * 128 + wr * 64 + m * 16 + fr; __VA_ARGS__ }
__device__ __forceinline__ u32x4 pack8(const f32x4 a, const f32x4 b) { u32x4 w; w.x = cvt_pk_bf16(a[0], a[1]); w.y = cvt_pk_bf16(a[2], a[3]); w.z = cvt_pk_bf16(b[0], b[1]); w.w = cvt_pk_bf16(b[2], b[3]); return w; }

struct EpiRowScale {
    static constexpr int MINST = 16;
    const ssq_t* ss; bf16_t* O0; int ld0; int split; bf16_t* O1; int ld1; int nstate; int state_cols; float* st_p; float* st_s; bf16_t* halo;
    __device__ __forceinline__ void operator()(Acc& acc, const Unit& u, int wr, int wc, int fr, int fq) const {
        int colt = u.pn * 256; bf16_t* base = O0; int ld = ld0; const int gcol0 = colt + wc * 32 + 8 * fq; const bool halo_tile = halo != nullptr && colt < 4096;
        if (colt >= split) { base = O1; ld = ld1; colt -= split; }
        const int col0 = colt + wc * 32 + 8 * fq;
        const bool st_tile = nstate > 0 && (u.pn * 256 < state_cols);
        EPI_ROWS(
            const float rs = ss ? rstd_of(ss, row) : 1.0f;
            bf16_t* rowp = base + (size_t)row * ld + col0;
            _Pragma("unroll") for (int bj = 0; bj < 2; ++bj) *(u32x4*)(rowp + bj * 128) = pack8(acc[ai][bj][m][0] * rs, acc[ai][bj][m][1] * rs);
            if (halo_tile && (row & 63) >= 61) { bf16_t* hp = halo + ((size_t)(row >> 6) * 3 + ((row & 63) - 61)) * 4096 + gcol0;
                _Pragma("unroll") for (int bj = 0; bj < 2; ++bj) *(u32x4*)(hp + bj * 128) = pack8(acc[ai][bj][m][0] * rs, acc[ai][bj][m][1] * rs); }
            if (st_tile) { int b, s, S; row_pos(row, b, s, S); const int j = s - (S - nstate);
                if (j >= 0) { float* dst = (row < MP ? st_p : st_s) + ((size_t)b * nstate + j) * state_cols + gcol0;
                    _Pragma("unroll") for (int bj = 0; bj < 2; ++bj) { *(f32x4*)(dst + bj * 128) = acc[ai][bj][m][0] * rs; *(f32x4*)(dst + bj * 128 + 4) = acc[ai][bj][m][1] * rs; } } }
        )
    }
};
struct EpiA1 {
    static constexpr int MINST = 16;
    const ssq_t* ss; bf16_t* BG; bf16_t* CV; float* st_p; float* st_s;
    __device__ __forceinline__ void operator()(Acc& acc, const Unit& u, int wr, int wc, int fr, int fq) const {
        if (u.pn < 8) {
            const int col0 = u.pn * 256 + wc * 32 + 8 * fq;
            EPI_ROWS(
                const float rs = rstd_of(ss, row); bf16_t* rowp = BG + (size_t)row * DM + col0;
                _Pragma("unroll") for (int bj = 0; bj < 2; ++bj) *(u32x4*)(rowp + bj * 128) = pack8(acc[ai][bj][m][0] * rs, acc[ai][bj][m][1] * rs);
            )
        } else {
            const int ch0 = (u.pn - 8) * 128 + wc * 32 + 8 * fq;
            EPI_ROWS(
                const float rs = rstd_of(ss, row); const float rs2 = rs * rs;
                const f32x4 c0 = acc[ai][0][m][0] * acc[ai][1][m][0] * rs2, c1 = acc[ai][0][m][1] * acc[ai][1][m][1] * rs2;
                *(u32x4*)(CV + (size_t)row * DM + ch0) = pack8(c0, c1);
                int b, s, S; row_pos(row, b, s, S); const int j = s - (S - 2);
                if (j >= 0) { float* dst = (row < MP ? st_p : st_s) + ((size_t)b * 2 + j) * DM + ch0; *(f32x4*)dst = c0; *(f32x4*)(dst + 4) = c1; }
            )
        }
    }
};
#ifndef RES16
#define RES16 1
#endif
template <bool PLEGATE> struct EpiResid {
    static constexpr int MINST = 16;
    float* H; const bf16_t* HBI; bf16_t* HB; ssq_t* ssn; const ssq_t* ssc; const bf16_t* PPB;
    __device__ __forceinline__ void operator()(Acc& acc, const Unit& u, int wr, int wc, int fr, int fq) const {
        const int col0 = u.pn * 256 + wc * 32 + 8 * fq;
        EPI_ROWS(
            float rs = 1.0f; if (PLEGATE) rs = rstd_of(ssc, row);
            float sq = 0.f;
            _Pragma("unroll") for (int bj = 0; bj < 2; ++bj) {
                const size_t off = (size_t)row * DM + col0 + bj * 128;
                f32x4 h0; f32x4 h1;
                if (RES16) { const u32x4 hw = *(const u32x4*)(HBI + off); h0 = (f32x4){bflo(hw.x), bfhi(hw.x), bflo(hw.y), bfhi(hw.y)}; h1 = (f32x4){bflo(hw.z), bfhi(hw.z), bflo(hw.w), bfhi(hw.w)}; }
                else { h0 = *(const f32x4*)(H + off); h1 = *(const f32x4*)(H + off + 4); }
                f32x4 a0 = acc[ai][bj][m][0], a1 = acc[ai][bj][m][1];
                if (PLEGATE) {
                    const u32x4 pw = *(const u32x4*)(PPB + off);
                    const f32x4 p0 = (f32x4){bflo(pw.x), bfhi(pw.x), bflo(pw.y), bfhi(pw.y)}, p1 = (f32x4){bflo(pw.z), bfhi(pw.z), bflo(pw.w), bfhi(pw.w)};
                    _Pragma("unroll") for (int e = 0; e < 4; ++e) { a0[e] = p0[e] * sigmoidf_(a0[e] * rs); a1[e] = p1[e] * sigmoidf_(a1[e] * rs); }
                }
                h0 += a0; h1 += a1;
                if (!RES16) { *(f32x4*)(H + off) = h0; *(f32x4*)(H + off + 4) = h1; }
                *(u32x4*)(HB + off) = pack8(h0, h1);
                sq += (h0[0] * h0[0] + h0[1] * h0[1]) + (h0[2] * h0[2] + h0[3] * h0[3]) + (h1[0] * h1[0] + h1[1] * h1[1]) + (h1[2] * h1[2] + h1[3] * h1[3]);
            }
            sq += __shfl_xor(sq, 16); sq += __shfl_xor(sq, 32);
            if (fq == 0) atomicAdd(ssn + row, ssq_fix(sq));
        )
    }
};

#ifdef DPP_FLIP
#define DPP_R1 0x12F
#define DPP_R2 0x12E
#else
#define DPP_R1 0x121
#define DPP_R2 0x122
#endif
__device__ __forceinline__ float dpp_ror1(float v) { return __int_as_float(__builtin_amdgcn_update_dpp(0, __float_as_int(v), DPP_R1, 0xf, 0xf, false)); }
__device__ __forceinline__ float dpp_ror2(float v) { return __int_as_float(__builtin_amdgcn_update_dpp(0, __float_as_int(v), DPP_R2, 0xf, 0xf, false)); }
struct EpiGlu {
    static constexpr int MINST = 16;
    const ssq_t* ss; bf16_t* ACT; float* XB; const float* wc; const float* bc; float* st_p; float* st_s;
    __device__ __forceinline__ void operator()(Acc& acc, const Unit& u, int wr, int wc_, int fr, int fq) const {
        const int j0 = u.pn * 128 + wc_ * 32 + 8 * fq;
#pragma unroll
        for (int ai = 0; ai < 2; ++ai)
#pragma unroll
            for (int m = 0; m < 4; ++m) { const float rs = rstd_of(ss, u.pm * 256 + ai * 128 + wr * 64 + m * 16 + fr);
#pragma unroll
                for (int bj = 0; bj < 2; ++bj) { acc[ai][bj][m][0] *= rs; acc[ai][bj][m][1] *= rs; } }
#pragma unroll
        for (int n = 0; n < 2; ++n) {
            const int jc = j0 + 4 * n;
            f32x4 wg[3], wu[3];
#pragma unroll
            for (int d = 0; d < 3; ++d) { wg[d] = *(const f32x4*)(wc + d * DFF2 + jc); wu[d] = *(const f32x4*)(wc + d * DFF2 + DFF + jc); }
            const f32x4 bg = *(const f32x4*)(bc + jc), bu = *(const f32x4*)(bc + DFF + jc);
#pragma unroll
            for (int ai = 0; ai < 2; ++ai) {
#pragma unroll
                for (int m = 0; m < 4; ++m) {
                    const int row = u.pm * 256 + ai * 128 + wr * 64 + m * 16 + fr, r64 = m * 16 + fr;
                    const f32x4 cg = acc[ai][0][m][n], cu = acc[ai][1][m][n];
                    const f32x4 pg = acc[ai][0][m > 0 ? m - 1 : 0][n], pu = acc[ai][1][m > 0 ? m - 1 : 0][n];
                    f32x4 g1, g2, u1, u2;
#pragma unroll
                    for (int e = 0; e < 4; ++e) {
                        g1[e] = DPPF(dpp_ror1(pg[e]), cg[e], 0x111, 0xf); g2[e] = DPPF(dpp_ror2(pg[e]), cg[e], 0x112, 0xf);
                        u1[e] = DPPF(dpp_ror1(pu[e]), cu[e], 0x111, 0xf); u2[e] = DPPF(dpp_ror2(pu[e]), cu[e], 0x112, 0xf);
                    }
                    const f32x4 ug = wg[0] * g2 + wg[1] * g1 + wg[2] * cg + bg, uu = wu[0] * u2 + wu[1] * u1 + wu[2] * cu + bu;
                    f32x4 o;
#pragma unroll
                    for (int e = 0; e < 4; ++e) o[e] = siluf_(ug[e]) * uu[e];
                    if (r64 >= 2) { u32x2 w; w.x = cvt_pk_bf16(o[0], o[1]); w.y = cvt_pk_bf16(o[2], o[3]); *(u32x2*)(ACT + (size_t)row * DFF + jc) = w; }
                    if (r64 < 2 || r64 >= 62) {
                        bf16_t* xb = (bf16_t*)XB + ((size_t)(row >> 6) * 4 + ((r64 + 2) & 3)) * DFF2 + jc;
                        { u32x2 wg_, wu_; wg_.x = cvt_pk_bf16(cg[0], cg[1]); wg_.y = cvt_pk_bf16(cg[2], cg[3]); wu_.x = cvt_pk_bf16(cu[0], cu[1]); wu_.y = cvt_pk_bf16(cu[2], cu[3]); *(u32x2*)xb = wg_; *(u32x2*)(xb + DFF) = wu_; }
                        if (r64 >= 62) { int b, s, S; row_pos(row, b, s, S);
                            if (s >= S - 2) { float* dst = (row < MP ? st_p : st_s) + ((size_t)b * 2 + (s - (S - 2))) * DFF2 + jc; *(f32x4*)dst = cg; *(f32x4*)(dst + DFF) = cu; } }
                    }
                }
            }
        }
    }
};
struct EpiNull { static constexpr int MINST = 0; __device__ __forceinline__ void operator()(Acc& acc, const Unit& u, int wr, int wc, int fr, int fq) const { asm volatile("" :: "v"(acc[0][0][0][0][0])); } };
struct EpiPlain {
    static constexpr int MINST = 16;
    bf16_t* O; int ld;
    __device__ __forceinline__ void operator()(Acc& acc, const Unit& u, int wr, int wc, int fr, int fq) const {
        const int col0 = u.pn * 256 + wc * 32 + 8 * fq;
        EPI_ROWS(
            bf16_t* rowp = O + (size_t)row * ld + col0;
            _Pragma("unroll") for (int bj = 0; bj < 2; ++bj) *(u32x4*)(rowp + bj * 128) = pack8(acc[ai][bj][m][0], acc[ai][bj][m][1]);
        )
    }
};
__device__ __forceinline__ int src_col(int cmap, int col_off, int n) {
    if (cmap == 1) { if (n < 2048) return n; const int t = (n - 2048) >> 8, w = (n - 2048) & 255; return w < 128 ? 2048 + 128 * t + w : 4096 + 128 * t + (w - 128); }
    if (cmap == 2) { const int t = n >> 8, w = n & 255; return w < 128 ? 128 * t + w : DFF + 128 * t + (w - 128); }
    return col_off + n;
}
__device__ __forceinline__ void prep_matrix(int wv, LAS float* tile, const float* W, int ldw, int K, int nrows, bf16_t* dst, const float* gain, int cmap, int col_off, int& tctr, const int G, const int c, const int row0 = 0) {
    const int tid = fresh_tid(wv);
    if (nrows >= 128) {
        const int ktiles = K >> 7, ntiles = nrows >> 7, total = ktiles * ntiles;
        int t = (int)((c + G - (tctr % G)) % G);
        const int lane = tid & 63, wid = tid >> 6, ks = (wid >> 2) * 64 + 8 * (lane >> 3), ns = (wid & 3) * 32 + 4 * (lane & 7);
        const __amdgpu_buffer_rsrc_t drs = __builtin_amdgcn_make_buffer_rsrc((void*)dst, 0, 0x7fffffff, 0x00020000);
        f32x4 v[8];
#define PREP_LOAD(tt) do { const int nt_ = (tt) / ktiles, kt_ = (tt) % ktiles; const float* src_ = W + (size_t)(kt_ * 128 + ks) * ldw + src_col(cmap, col_off, row0 + nt_ * 128) + ns; \
            _Pragma("unroll") for (int p = 0; p < 8; ++p) v[p] = __builtin_nontemporal_load((const f32x4*)(src_ + (size_t)p * ldw)); } while (0)
        if (t < total) PREP_LOAD(t);
        for (; t < total; t += G) {
            const int nt = t / ktiles, kt = t % ktiles, n0 = nt * 128, k0 = kt * 128;
            f32x4 g0 = {1.f, 1.f, 1.f, 1.f}, g1 = g0; if (gain) { g0 = *(const f32x4*)(gain + k0 + ks); g1 = *(const f32x4*)(gain + k0 + ks + 4); }
            u32x4 w[4];
#pragma unroll
            for (int e = 0; e < 4; ++e) { w[e].x = cvt_pk_bf16(v[0][e] * g0[0], v[1][e] * g0[1]); w[e].y = cvt_pk_bf16(v[2][e] * g0[2], v[3][e] * g0[3]);
                w[e].z = cvt_pk_bf16(v[4][e] * g1[0], v[5][e] * g1[1]); w[e].w = cvt_pk_bf16(v[6][e] * g1[2], v[7][e] * g1[3]); }
            if (t + G < total) PREP_LOAD(t + G);
            const unsigned d_ = (unsigned)(((size_t)(row0 + n0 + ns) * K + k0 + ks) * 2);
#pragma unroll
            for (int e = 0; e < 4; ++e) __builtin_amdgcn_raw_buffer_store_b128(w[e], drs, (int)(d_ + (unsigned)e * (unsigned)K * 2u), 0, WT_AUX);
        }
#undef PREP_LOAD
        tctr += total;
    } else {
        const int ktiles = K >> 6, ntiles = nrows >> 6, total = ktiles * ntiles;
        int t = (int)((c + G - (tctr % G)) % G);
        for (; t < total; t += G) {
            const int nt = t / ktiles, kt = t % ktiles, n0 = nt * 64, k0 = kt * 64, ns0 = src_col(cmap, col_off, n0);
            const int ty = tid >> 4, tx = tid & 15;
#pragma unroll
            for (int p = 0; p < 2; ++p) { const int k = k0 + ty + 32 * p; const f32x4 v = *(const f32x4*)(W + (size_t)k * ldw + ns0 + 4 * tx); const float g = gain ? gain[k] : 1.0f;
#pragma unroll
                for (int e = 0; e < 4; ++e) tile[(4 * tx + e) * 129 + ty + 32 * p] = v[e] * g; }
            __syncthreads();
            { const int n = tid >> 3, kg = tid & 7; const LAS float* src = tile + n * 129 + 8 * kg;
              u32x4 w; w.x = cvt_pk_bf16(src[0], src[1]); w.y = cvt_pk_bf16(src[2], src[3]); w.z = cvt_pk_bf16(src[4], src[5]); w.w = cvt_pk_bf16(src[6], src[7]);
              *(u32x4*)(dst + (size_t)(n0 + n) * K + k0 + 8 * kg) = w; }
            __syncthreads();
        }
        tctr += total;
    }
}
#ifndef JOBSITES
#define JOBSITES 0, 1, 6, 6, 0, 0, 3, 0, 5,  1, 1, 1, 1, 1, 1, 0,  2, 2, 2, 3, 4, 4, 0,  5, 5, 5, 5, 5, 5, 0,  7, 7, 7, 7, 8, 7, 0
#endif
constexpr int job_site(int j) { constexpr int t[37] = {JOBSITES}; return t[j]; }
#ifndef JOBSITES2
#define JOBSITES2 0
#endif
constexpr bool job_in(int j, int site) { constexpr int t2[37] = {JOBSITES2}; return site == 99 ? t2[j] == 1 : job_site(j) == site; }
template <int SITE>
__device__ __forceinline__ void prep_jobs(const Params& P, int wv, LAS unsigned char* lds, const int G, const int c) {
    unsigned char* ws = P.ws; asm volatile("" : "+s"(ws)); LAS float* tile = (LAS float*)lds; int tctr = 0;
#define JOB(j, ...) if (job_in(j, SITE)) prep_matrix(wv, tile, __VA_ARGS__, tctr, G, c);
    JOB(0, P.in[I_WAIN], 6144, 2048, 6144, (bf16_t*)(ws + WS_WAIN), P.in[I_GMIX], 1, 0)
    JOB(1, P.in[I_WAOUT], 2048, 2048, 2048, (bf16_t*)(ws + WS_WAOUT), nullptr, 0, 0)
    JOB(2, P.in[I_WAIN] + (size_t)2048 * 6144, 6144, 2048, 6144, (bf16_t*)(ws + WS_WAIN) + (size_t)6144 * 2048, P.in[I_GMIX] + 3 * 2048, 1, 0)
    JOB(3, P.in[I_WAOUT] + (size_t)2048 * 2048, 2048, 2048, 2048, (bf16_t*)(ws + WS_WAOUT) + (size_t)2048 * 2048, nullptr, 0, 0)
    JOB(4, P.in[I_WBIN], DNIN, 2048, 12288, (bf16_t*)(ws + WS_WBIN), P.in[I_GMIX] + 1 * 2048, 0, 0)
    JOB(5, P.in[I_WBIN], DNIN, 2048, 64, (bf16_t*)(ws + WS_WBBA), P.in[I_GMIX] + 1 * 2048, 0, 12288)
    JOB(6, P.in[I_WBOUT], 2048, 4096, 2048, (bf16_t*)(ws + WS_WBOUT), nullptr, 0, 0)
    JOB(7, P.in[I_WCQKV], 6144, 2048, 6144, (bf16_t*)(ws + WS_WCQKV), P.in[I_GMIX] + 2 * 2048, 0, 0)
    JOB(8, P.in[I_WCOUT], 2048, 2048, 2048, (bf16_t*)(ws + WS_WCOUT), nullptr, 0, 0)
#define JOB_FUP(i, q) if (job_in(9 + 7 * i + q, SITE)) prep_matrix(wv, tile, P.in[I_WFUP] + (size_t)i * 2048 * DFF2, DFF2, 2048, DFF2 / 4, (bf16_t*)(ws + WS_WFUP) + (size_t)i * DFF2 * 2048, P.in[I_GFFN] + i * 2048, 2, 0, tctr, G, c, q * (DFF2 / 4));
#define JOBS_FFN(i) JOB_FUP(i, 0) JOB_FUP(i, 1) JOB_FUP(i, 2) JOB_FUP(i, 3) \
    JOB(13 + 7 * i, P.in[I_WFDOWN] + (size_t)i * DFF * 2048, 2048, DFF, 2048, (bf16_t*)(ws + WS_WFDOWN) + (size_t)i * 2048 * DFF, nullptr, 0, 0) \
    JOB(14 + 7 * i, P.in[I_WPG] + (size_t)i * 2048 * 2048, 2048, 2048, 2048, (bf16_t*)(ws + WS_WPG) + (size_t)i * 2048 * 2048, P.in[I_GPLE] + i * 2048, 0, 0) \
    JOB(15 + 7 * i, P.in[I_WPP] + (size_t)i * PLE * 2048, 2048, PLE, 2048, (bf16_t*)(ws + WS_WPP) + (size_t)i * 2048 * PLE, nullptr, 0, 0)
    JOBS_FFN(0) JOBS_FFN(1) JOBS_FFN(2) JOBS_FFN(3)
#undef JOBS_FFN
#undef JOB_FUP
#undef JOB
}
template <int SITE>
__device__ __forceinline__ void prep_fill(const Params& P, int wv, LAS unsigned char* lds, int nunits, int G, int wg) {
    const int rem = nunits % G, G2 = rem ? G - rem : G, c2 = rem ? wg - rem : wg;
    if (c2 >= 0) prep_jobs<SITE>(P, wv, lds, G2, c2);
}
__device__ __forceinline__ void phase_prologue(const Params& P, int wv, LAS unsigned char* lds) {
    unsigned char* ws = P.ws;
    prep_jobs<0>(P, wv, lds, (int)gridDim.x, (int)blockIdx.x);
    const int tid_ = fresh_tid(wv), lane = tid_ & 63, gw = blockIdx.x * 8 + (tid_ >> 6), nw = gridDim.x * 8;
    float* H = (float*)(ws + WS_H); bf16_t* HB = (bf16_t*)(ws + WS_HB); ssq_t* SS0 = (ssq_t*)(ws + WS_SS);
    {
        f32x4 ca[4], cb[4], na[4], nb[4];
#define XH_LOAD(A_, B_, row_) do { const int r_ = (row_); const float* src_ = r_ < MP ? P.in[I_XP] + (size_t)r_ * DM : P.in[I_XS] + (size_t)(r_ - MP) * DM; \
            _Pragma("unroll") for (int j = 0; j < 4; ++j) { const int c_ = (j * 64 + lane) * 8; A_[j] = *(const f32x4*)(src_ + c_); B_[j] = *(const f32x4*)(src_ + c_ + 4); } } while (0)
#pragma unroll
        for (int j = 0; j < 4; ++j) { ca[j] = (f32x4){0.f, 0.f, 0.f, 0.f}; cb[j] = ca[j]; na[j] = ca[j]; nb[j] = ca[j]; }
        int row = gw;
        if (row < MT) XH_LOAD(ca, cb, row);
        for (; row < MT; row += nw) {
            if (row + nw < MT) XH_LOAD(na, nb, row + nw);
            float sq = 0.f;
#pragma unroll
            for (int j = 0; j < 4; ++j) {
                const int c = (j * 64 + lane) * 8;
                const f32x4 a = ca[j], b = cb[j];
                *(u32x4*)(HB + (size_t)row * DM + c) = pack8(a, b);
                sq += (a[0] * a[0] + a[1] * a[1]) + (a[2] * a[2] + a[3] * a[3]) + (b[0] * b[0] + b[1] * b[1]) + (b[2] * b[2] + b[3] * b[3]);
            }
            sq = wave_sum(sq);
            if (lane == 0) SS0[row] = ssq_fix(sq);
#pragma unroll
            for (int j = 0; j < 4; ++j) { ca[j] = na[j]; cb[j] = nb[j]; }
        }
#undef XH_LOAD
    }
    { ssq_t* SSz = (ssq_t*)(ws + WS_SS) + MT; const size_t nz = (size_t)(NSS - 1) * MT;
      for (size_t i = (size_t)blockIdx.x * NTH + fresh_tid(wv); i < nz; i += (size_t)gridDim.x * NTH) SSz[i] = 0ull; }
    bf16_t* PB = (bf16_t*)(ws + WS_PB);
    const size_t n8 = (size_t)4 * MT * PLE / 8;
    const size_t pstep = (size_t)gridDim.x * NTH;
    for (size_t i0 = (size_t)blockIdx.x * NTH + fresh_tid(wv); i0 < n8; i0 += 4 * pstep) {
        f32x4 pa[4], pb[4];
#pragma unroll
        for (int u = 0; u < 4; ++u) { const size_t i = i0 + u * pstep; pa[u] = (f32x4){0.f, 0.f, 0.f, 0.f}; pb[u] = pa[u];
            if (i < n8) { const size_t e = i * 8; const int L = (int)(e / ((size_t)MT * PLE)); const size_t r = e % ((size_t)MT * PLE); const int row = (int)(r / PLE), c = (int)(r % PLE);
                const float* src = row < MP ? P.in[I_PP] + ((size_t)L * MP + row) * PLE + c : P.in[I_PS] + ((size_t)L * MS + (row - MP)) * PLE + c;
                pa[u] = *(const f32x4*)src; pb[u] = *(const f32x4*)(src + 4); } }
#pragma unroll
        for (int u = 0; u < 4; ++u) { const size_t i = i0 + u * pstep; if (i < n8) *(u32x4*)(PB + i * 8) = pack8(pa[u], pb[u]); }
    }
}

__device__ __forceinline__ void ld8(const bf16_t* p, float (&x)[8]) { const u32x4 w = *(const u32x4*)p; x[0] = bflo(w.x); x[1] = bfhi(w.x); x[2] = bflo(w.y); x[3] = bfhi(w.y); x[4] = bflo(w.z); x[5] = bfhi(w.z); x[6] = bflo(w.w); x[7] = bfhi(w.w); }
__device__ __forceinline__ void phase_ea(const Params& P, int wv, int j  ) {
    unsigned char* ws = P.ws; const bf16_t* BG = (const bf16_t*)(ws + AR_BG); const bf16_t* CV = (const bf16_t*)(ws + AR_CV); bf16_t* AA = (bf16_t*)(ws + AR_AA);
    const float* wc = P.in[I_WACONV] + (size_t)j * 3 * DM; const float* hist = P.in[I_STA] + (size_t)j * NBS * 2 * DM;
    const int gt = blockIdx.x * NTH + fresh_tid(wv), nthr = gridDim.x * NTH, c = (gt & 255) * 8, walker = gt >> 8, nwalk = nthr >> 8;
    const int per = (MT + nwalk - 1) / nwalk, r0 = walker * per, r1 = (r0 + per) < MT ? (r0 + per) : MT;
    float w0[8], w1[8], w2[8];
#pragma unroll
    for (int e = 0; e < 8; ++e) { w0[e] = wc[c + e]; w1[e] = wc[DM + c + e]; w2[e] = wc[2 * DM + c + e]; }
    float x1[8], x2[8];
#pragma unroll
    for (int e = 0; e < 8; ++e) { x1[e] = 0.f; x2[e] = 0.f; }
    if (r0 < r1) { int b, s, S; row_pos(r0, b, s, S); if (s >= 1) ld8(CV + (size_t)(r0 - 1) * DM + c, x1); if (s >= 2) ld8(CV + (size_t)(r0 - 2) * DM + c, x2); }
    constexpr int U = 4;
    for (int rowb = r0; rowb < r1; rowb += U) {
        u32x4 xr[U], gr[U];
#pragma unroll
        for (int u = 0; u < U; ++u) { xr[u] = (u32x4){0u, 0u, 0u, 0u}; gr[u] = xr[u]; if (rowb + u < r1) { xr[u] = *(const u32x4*)(CV + (size_t)(rowb + u) * DM + c); gr[u] = *(const u32x4*)(BG + (size_t)(rowb + u) * DM + c); } }
#pragma unroll
        for (int u = 0; u < U; ++u) { const int row = rowb + u;
            if (row < r1) {
                int b, s, S; row_pos(row, b, s, S);
                float x0[8], g[8];
                x0[0] = bflo(xr[u].x); x0[1] = bfhi(xr[u].x); x0[2] = bflo(xr[u].y); x0[3] = bfhi(xr[u].y); x0[4] = bflo(xr[u].z); x0[5] = bfhi(xr[u].z); x0[6] = bflo(xr[u].w); x0[7] = bfhi(xr[u].w);
                g[0] = bflo(gr[u].x); g[1] = bfhi(gr[u].x); g[2] = bflo(gr[u].y); g[3] = bfhi(gr[u].y); g[4] = bflo(gr[u].z); g[5] = bfhi(gr[u].z); g[6] = bflo(gr[u].w); g[7] = bfhi(gr[u].w);
                if (s < 2) {
                    if (row >= MP) { const float* h1 = hist + ((size_t)b * 2 + 1) * DM + c; const float* h0 = hist + ((size_t)b * 2) * DM + c;
#pragma unroll
                        for (int e = 0; e < 8; ++e) { if (s == 0) { x1[e] = h1[e]; x2[e] = h0[e]; } else x2[e] = h1[e]; } }
                    else {
#pragma unroll
                        for (int e = 0; e < 8; ++e) { if (s == 0) { x1[e] = 0.f; x2[e] = 0.f; } else x2[e] = 0.f; } }
                }
                float o[8];
#pragma unroll
                for (int e = 0; e < 8; ++e) { o[e] = g[e] * (w0[e] * x2[e] + w1[e] * x1[e] + w2[e] * x0[e]); x2[e] = x1[e]; x1[e] = x0[e]; }
                u32x4 w; w.x = cvt_pk_bf16(o[0], o[1]); w.y = cvt_pk_bf16(o[2], o[3]); w.z = cvt_pk_bf16(o[4], o[5]); w.w = cvt_pk_bf16(o[6], o[7]);
                *(u32x4*)(AA + (size_t)row * DM + c) = w;
            } }
    }
}

__device__ __forceinline__ f32x4 ld4bf(const bf16_t* p) { const u32x2 w = *(const u32x2*)p; return (f32x4){bflo(w.x), bfhi(w.x), bflo(w.y), bfhi(w.y)}; }
__device__ __forceinline__ void phase_ef(const Params& P, int wv, int L) {
    unsigned char* ws = P.ws; const bf16_t* XB = (const bf16_t*)(ws + AR_XB); bf16_t* ACT = (bf16_t*)(ws + AR_ACT);
    const float* wc = P.in[I_WFCONV] + (size_t)L * 3 * DFF2; const float* bc = P.in[I_BFCONV] + (size_t)L * DFF2; const float* hist = P.in[I_STF] + (size_t)L * NBS * 2 * DFF2;
    const int per_row = DFF / 4, total = (MT / 64) * 2 * per_row;
    constexpr int U = 2;
    const int step = gridDim.x * NTH;
    for (int i0 = blockIdx.x * NTH + fresh_tid(wv); i0 < total; i0 += U * step) {
        f32x4 x[U][2][3], wt[U][2][4];
#pragma unroll
        for (int u = 0; u < U; ++u) { const int i = i0 + u * step;
#pragma unroll
            for (int h = 0; h < 2; ++h) {
#pragma unroll
                for (int d = 0; d < 3; ++d) x[u][h][d] = (f32x4){0.f, 0.f, 0.f, 0.f};
#pragma unroll
                for (int d = 0; d < 4; ++d) wt[u][h][d] = (f32x4){0.f, 0.f, 0.f, 0.f}; }
            if (i < total) {
                const int blk = i / (2 * per_row), r = (i / per_row) & 1, c = (i % per_row) * 4, row = blk * 64 + r; int b, s, S; row_pos(row, b, s, S);
#pragma unroll
                for (int h = 0; h < 2; ++h) {
                    const int cc = c + h * DFF;
                    x[u][h][2] = ld4bf(XB + ((size_t)blk * 4 + 2 + r) * DFF2 + cc);
#pragma unroll
                    for (int d = 1; d <= 2; ++d) {
                        const int p = r - d;
                        if (p >= 0) x[u][h][2 - d] = ld4bf(XB + ((size_t)blk * 4 + 2 + p) * DFF2 + cc);
                        else if (s - d >= 0) x[u][h][2 - d] = ld4bf(XB + ((size_t)(blk - 1) * 4 + (2 + p)) * DFF2 + cc);
                        else if (row >= MP) x[u][h][2 - d] = *(const f32x4*)(hist + ((size_t)b * 2 + (2 + (s - d))) * DFF2 + cc);
                    }
                    wt[u][h][0] = *(const f32x4*)(wc + cc); wt[u][h][1] = *(const f32x4*)(wc + DFF2 + cc); wt[u][h][2] = *(const f32x4*)(wc + 2 * DFF2 + cc); wt[u][h][3] = *(const f32x4*)(bc + cc);
                }
            } }
#pragma unroll
        for (int u = 0; u < U; ++u) { const int i = i0 + u * step;
            if (i < total) {
                const int blk = i / (2 * per_row), r = (i / per_row) & 1, c = (i % per_row) * 4, row = blk * 64 + r;
                const f32x4 yg = wt[u][0][0] * x[u][0][0] + wt[u][0][1] * x[u][0][1] + wt[u][0][2] * x[u][0][2] + wt[u][0][3];
                const f32x4 yu = wt[u][1][0] * x[u][1][0] + wt[u][1][1] * x[u][1][1] + wt[u][1][2] * x[u][1][2] + wt[u][1][3];
                f32x4 o;
#pragma unroll
                for (int e2 = 0; e2 < 4; ++e2) o[e2] = siluf_(yg[e2]) * yu[e2];
                u32x2 w; w.x = cvt_pk_bf16(o[0], o[1]); w.y = cvt_pk_bf16(o[2], o[3]);
                *(u32x2*)(ACT + (size_t)row * DFF + c) = w;
            } }
    }
}


__device__ __forceinline__ void phase_reduce(const Params& P, int wv, int K, const float* PART, ssq_t* ssn, const ssq_t* ssc  , const bf16_t* HBI, bf16_t* HB) {
    unsigned char* ws = P.ws; float* H = (float*)(ws + WS_H); const bf16_t* PPB = (const bf16_t*)(ws + AR_PPB);
    pg8::StaticOrder S; S.init(MT, DM, K, (int)gridDim.x, 0, true);
    if (S.nreg == S.nwg) return;
    const int nleft = S.nwg - S.nreg;
    const int tid_ = fresh_tid(wv), lane = tid_ & 63, gw = blockIdx.x * 8 + (tid_ >> 6), nw = gridDim.x * 8;
    constexpr int U = 4;
    for (int tr0 = gw; tr0 < nleft * 256; tr0 += nw * U) {
        u32x2 pv[U][8]; u32x2 hw[U], pw[U]; ssq_t sr[U]; size_t offs[U]; int rows[U];
#pragma unroll
        for (int u = 0; u < U; ++u) { const int tr = tr0 + u * nw; pw[u] = (u32x2){0u, 0u}; sr[u] = 0ull; hw[u] = (u32x2){0u, 0u}; offs[u] = 0; rows[u] = 0;
            if (tr < nleft * 256) {
                const int j = tr >> 8, r = tr & 255, pq = S.map(S.nreg + j);
                rows[u] = (pq >> 16) * 256 + r; offs[u] = (size_t)rows[u] * DM + (pq & 0xffff) * 256 + 4 * lane;
#pragma unroll
                for (int k = 0; k < 8; ++k) pv[u][k] = *(const u32x2*)((const bf16_t*)PART + (size_t)(j * 8 + k) * 65536 + (size_t)r * 256 + 4 * lane);
                hw[u] = *(const u32x2*)(HBI + offs[u]);
                if (ssc) { sr[u] = ssc[rows[u]]; pw[u] = *(const u32x2*)(PPB + offs[u]); }
            } }
#pragma unroll
        for (int u = 0; u < U; ++u) { const int tr = tr0 + u * nw;
            if (tr < nleft * 256) {
                f32x4 s = (f32x4){0.f, 0.f, 0.f, 0.f};
#pragma unroll
                for (int k = 0; k < 8; ++k) s += (f32x4){bflo(pv[u][k].x), bfhi(pv[u][k].x), bflo(pv[u][k].y), bfhi(pv[u][k].y)};
                f32x4 h = (f32x4){bflo(hw[u].x), bfhi(hw[u].x), bflo(hw[u].y), bfhi(hw[u].y)};
                if (ssc) { const float rs = rsqrtf((float)sr[u] * (1.0f / (2048.0f * SSQ_SCALE)) + EPS);
                    h[0] += bflo(pw[u].x) * sigmoidf_(s[0] * rs); h[1] += bfhi(pw[u].x) * sigmoidf_(s[1] * rs); h[2] += bflo(pw[u].y) * sigmoidf_(s[2] * rs); h[3] += bfhi(pw[u].y) * sigmoidf_(s[3] * rs); }
                else h += s;
                u32x2 w; w.x = cvt_pk_bf16(h[0], h[1]); w.y = cvt_pk_bf16(h[2], h[3]); *(u32x2*)(HB + offs[u]) = w;
                float sq = (h[0] * h[0] + h[1] * h[1]) + (h[2] * h[2] + h[3] * h[3]); sq = wave_sum(sq);
                if (lane == 0) atomicAdd(ssn + rows[u], ssq_fix(sq));
            } }
    }
}

__device__ __forceinline__ void phase_final(const Params& P, int wv, const bf16_t* HB) {
    unsigned char* ws = P.ws; const float* H = (const float*)(ws + WS_H); const ssq_t* ss = (const ssq_t*)(ws + WS_SS) + (size_t)12 * MT; const float* g = P.in[I_GFIN];
    const int tid_ = fresh_tid(wv), lane = tid_ & 63, gw = blockIdx.x * 8 + (tid_ >> 6), nw = gridDim.x * 8;
    for (int rowb = gw; rowb < MT; rowb += 2 * nw) {
        u32x2 hw[2][8]; float rs[2];
#pragma unroll
        for (int u = 0; u < 2; ++u) { const int row = rowb + u * nw; rs[u] = 0.f;
#pragma unroll
            for (int j = 0; j < 8; ++j) hw[u][j] = (u32x2){0u, 0u};
            if (row < MT) { rs[u] = rstd_of(ss, row);
#pragma unroll
                for (int j = 0; j < 8; ++j) hw[u][j] = *(const u32x2*)(HB + (size_t)row * DM + (j * 64 + lane) * 4); } }
#pragma unroll
        for (int u = 0; u < 2; ++u) { const int row = rowb + u * nw;
            if (row < MT) {
                float* dst = row < MP ? P.out + O_YP + (size_t)row * DM : P.out + O_YS + (size_t)(row - MP) * DM;
#pragma unroll
                for (int j = 0; j < 8; ++j) { const int c = (j * 64 + lane) * 4; const u32x2 w = hw[u][j];
                    const f32x4 a = (f32x4){bflo(w.x), bfhi(w.x), bflo(w.y), bfhi(w.y)};
                    *(f32x4*)(dst + c) = a * rs[u] * *(const f32x4*)(g + c); }
            } }
    }
}

__device__ __forceinline__ void phase_ba(const Params& P, int wv, const ssq_t* ss, const bf16_t* HB) {
    unsigned char* ws = P.ws; const bf16_t* WBA = (const bf16_t*)(ws + WS_WBBA); float* BA = (float*)(ws + WS_BA);
    const int tid_ = fresh_tid(wv), lane = tid_ & 63, fr = lane & 15, fq = lane >> 4, gw = (tid_ >> 6) * gridDim.x + blockIdx.x, nw = gridDim.x * 8;
    for (int rt = gw; rt < MT / 16; rt += nw) {
        f32x4 acc[4];
#pragma unroll
        for (int n = 0; n < 4; ++n) acc[n] = (f32x4){0.f, 0.f, 0.f, 0.f};
        const bf16_t* ap = HB + (size_t)(rt * 16 + fr) * DM + 8 * fq;
#pragma unroll 8
        for (int k0 = 0; k0 < DM; k0 += 32) {
            const bf16x8 a = *(const bf16x8*)(ap + k0);
#pragma unroll
            for (int n = 0; n < 4; ++n) { const bf16x8 b = *(const bf16x8*)(WBA + (size_t)(n * 16 + fr) * DM + k0 + 8 * fq); acc[n] = __builtin_amdgcn_mfma_f32_16x16x32_bf16(b, a, acc[n], 0, 0, 0); }
        }
        const int row = rt * 16 + fr; const float rs = rstd_of(ss, row);
#pragma unroll
        for (int n = 0; n < 4; ++n) { f32x4 v = acc[n] * rs;
#pragma unroll
            for (int r = 0; r < 4; ++r) { if (n < 2) v[r] = sigmoidf_(v[r]); else { const int hv = (n - 2) * 16 + 4 * fq + r; const float aa = v[r] + P.in[I_DTB][hv]; v[r] = -__expf(P.in[I_ALOG][hv]) * (aa > 20.f ? aa : log1pf(__expf(aa))); } }
            *(f32x4*)(BA + (size_t)row * 64 + n * 16 + 4 * fq) = v; }
    }
}
__device__ __forceinline__ void phase_ec(const Params& P, int wv, LAS unsigned char* lds) {
    unsigned char* ws = P.ws; bf16_t* QKV = (bf16_t*)(ws + AR_QKV); bf16_t* VTP = (bf16_t*)(ws + AR_VTP); bf16_t* VTS = (bf16_t*)(ws + AR_VTS); bf16_t* KS = (bf16_t*)(ws + AR_KS);
    const float* gq = P.in[I_GCQ]; const float* gk = P.in[I_GCK];
    LAS bf16_t* tv = (LAS bf16_t*)lds;
    const int tid = fresh_tid(wv), lane = tid & 63, wid = tid >> 6;
    const int n_main = (MT / 64) * 16, n_hist = NBS * 16 * 8;
    const float* ck = P.in[I_CK]; const float* cv = P.in[I_CV];
    unsigned cur[32], nxt[32];
#define EC_ISSUE(BUF, it_) do { const int item_ = (it_); \
        if (item_ < n_main) { const int chunk_ = item_ >> 4, h_ = item_ & 15; \
            _Pragma("unroll") for (int i = 0; i < 8; ++i) { const unsigned* qp_ = (const unsigned*)(QKV + (size_t)(chunk_ * 64 + wid * 8 + i) * 6144 + h_ * 128) + lane; BUF[i] = qp_[0]; BUF[8 + i] = qp_[1024]; BUF[16 + i] = qp_[2048]; BUF[24 + i] = 0u; } } \
        else { const int it2_ = item_ - n_main, b_ = it2_ >> 7, h_ = (it2_ >> 3) & 15, jc_ = it2_ & 7; \
            _Pragma("unroll") for (int i = 0; i < 8; ++i) { const size_t o_ = (((size_t)b_ * 512 + jc_ * 64 + wid * 8 + i) * 16 + h_) * 128 + 2 * lane; const f32x2 kk_ = *(const f32x2*)(ck + o_), vv_ = *(const f32x2*)(cv + o_); \
                BUF[i] = __float_as_uint(kk_.x); BUF[8 + i] = __float_as_uint(kk_.y); BUF[16 + i] = __float_as_uint(vv_.x); BUF[24 + i] = __float_as_uint(vv_.y); } } } while (0)
    const int n_items = n_main + n_hist, G = (int)gridDim.x;
    int item = blockIdx.x;
#pragma unroll
    for (int i = 0; i < 32; ++i) { cur[i] = 0u; nxt[i] = 0u; }
    if (item < n_items) EC_ISSUE(cur, item);
    for (; item < n_items; item += G) {
        bf16_t* vt_dst; int vt_ld;
        if (item < n_main) {
            const int chunk = item >> 4, h = item & 15, row0 = chunk * 64;
            const float gq0 = gq[2 * lane], gq1 = gq[2 * lane + 1], gk0 = gk[2 * lane], gk1 = gk[2 * lane + 1];
#pragma unroll
            for (int i = 0; i < 8; ++i) {
                const int t = wid * 8 + i, row = row0 + t; int b, s, S; row_pos(row, b, s, S);
                unsigned* qp = (unsigned*)(QKV + (size_t)row * 6144 + h * 128) + lane; unsigned* kp = qp + 1024;
                const unsigned qw = cur[i], kw = cur[8 + i], vw = cur[16 + i];
                float q0 = bflo(qw), q1 = bfhi(qw), k0 = bflo(kw), k1 = bfhi(kw);
                const float qs = wave_sum(q0 * q0 + q1 * q1), ks = wave_sum(k0 * k0 + k1 * k1);
                const float rq = rsqrtf(qs * (1.0f / 128.0f) + EPS) * 0.08838834764831845f, rk = rsqrtf(ks * (1.0f / 128.0f) + EPS);
                q0 *= rq * gq0; q1 *= rq * gq1; k0 *= rk * gk0; k1 *= rk * gk1;
                *qp = cvt_pk_bf16(q0, q1); const unsigned kn = cvt_pk_bf16(k0, k1); *kp = kn;
                *(LAS unsigned*)(tv + t * 130 + 2 * lane) = vw;
                if (row < MP) { if (s >= SEQ - 512) { const size_t o = (((size_t)b * 512 + (s - (SEQ - 512))) * 16 + h) * 128 + 2 * lane;
                        *(f32x2*)(P.out + O_PCK + o) = (f32x2){k0, k1}; *(f32x2*)(P.out + O_PCV + o) = (f32x2){bflo(vw), bfhi(vw)}; } }
                else { const size_t o = (((size_t)b * 64 + s) * 16 + h) * 128 + 2 * lane;
                    *(f32x2*)(P.out + O_SCK + o) = (f32x2){k0, k1}; *(f32x2*)(P.out + O_SCV + o) = (f32x2){bflo(vw), bfhi(vw)};
                    *(unsigned*)(KS + (((size_t)b * 576 + 512 + s) * 16 + h) * 128 + 2 * lane) = kn; }
            }
            if (row0 < MP) { const int b = row0 >> 12, s0 = row0 & 4095; vt_dst = VTP + ((size_t)(b * 16 + h) * 128) * 4096 + s0; vt_ld = 4096; }
            else { const int b = (row0 - MP) >> 6; vt_dst = VTS + ((size_t)(b * 16 + h) * 128) * 576 + 512; vt_ld = 576; }
        } else {
            const int it = item - n_main, b = it >> 7, h = (it >> 3) & 15, jc = it & 7;
#pragma unroll
            for (int i = 0; i < 8; ++i) { const int t = wid * 8 + i;
                *(unsigned*)(KS + (((size_t)b * 576 + jc * 64 + t) * 16 + h) * 128 + 2 * lane) = cvt_pk_bf16(__uint_as_float(cur[i]), __uint_as_float(cur[8 + i]));
                *(LAS unsigned*)(tv + t * 130 + 2 * lane) = cvt_pk_bf16(__uint_as_float(cur[16 + i]), __uint_as_float(cur[24 + i]));
            }
            vt_dst = VTS + ((size_t)(b * 16 + h) * 128) * 576 + jc * 64; vt_ld = 576;
        }
        if (item + G < n_items) EC_ISSUE(nxt, item + G);
        __syncthreads();
        { const int d = tid >> 2, tg = tid & 3; unsigned w[8];
#pragma unroll
          for (int e = 0; e < 8; ++e) w[e] = (unsigned)tv[(16 * tg + 2 * e) * 130 + d] | ((unsigned)tv[(16 * tg + 2 * e + 1) * 130 + d] << 16);
          bf16_t* dp = vt_dst + (size_t)d * vt_ld + 16 * tg;
          *(u32x4*)dp = (u32x4){w[0], w[1], w[2], w[3]}; *(u32x4*)(dp + 8) = (u32x4){w[4], w[5], w[6], w[7]}; }
        __syncthreads();
#pragma unroll
        for (int i = 0; i < 32; ++i) cur[i] = nxt[i];
    }
#undef EC_ISSUE
}

__device__ __forceinline__ void phase_att_sample(const Params& P, int wv) {
    unsigned char* ws = P.ws; const bf16_t* QKV = (const bf16_t*)(ws + AR_QKV); const bf16_t* VTP = (const bf16_t*)(ws + AR_VTP); const bf16_t* VTS = (const bf16_t*)(ws + AR_VTS);
    const bf16_t* KS = (const bf16_t*)(ws + AR_KS); bf16_t* OATT = (bf16_t*)(ws + AR_OATT); const float* relb = P.in[I_RELB];
    const int tid_ = fresh_tid(wv), lane = tid_ & 63, fr = lane & 15, fq = lane >> 4, gw = (tid_ >> 6) * gridDim.x + blockIdx.x, nw = gridDim.x * 8;
    const int n_items = (MT / 64) * 16;
    for (int wi = 4096 * 2 + gw; wi < n_items * 2; wi += nw) {
        const int item = wi >> 1, qs = wi & 1;
        int c, h, row0, kstride, vstride; const bf16_t* Kb; const bf16_t* Vb;
        if (item < 4096) { const int b = item >> 10; c = (item >> 4) & 63; h = item & 15; row0 = b * 4096 + c * 64 + qs * 32;
            Kb = QKV + (size_t)(b * 4096) * 6144 + 2048 + h * 128; kstride = 6144; Vb = VTP + ((size_t)(b * 16 + h) * 128) * 4096; vstride = 4096; }
        else { const int it = item - 4096, b = it >> 4; h = it & 15; c = 8; row0 = MP + b * 64 + qs * 32;
            Kb = KS + (size_t)(b * 576) * 2048 + h * 128; kstride = 2048; Vb = VTS + ((size_t)(b * 16 + h) * 128) * 576; vstride = 576; }
        const float* bias = relb + h * 257;
        bf16x8 qf[2][4];
#pragma unroll
        for (int qt = 0; qt < 2; ++qt) { const bf16_t* qp = QKV + (size_t)(row0 + 16 * qt + fr) * 6144 + h * 128 + 8 * fq;
#pragma unroll
            for (int ks = 0; ks < 4; ++ks) qf[qt][ks] = *(const bf16x8*)(qp + 32 * ks); }
        const int qpos0 = c * 64 + qs * 32 + fr;
        float bmx = fmaxf(fmaxf(bias[lane], bias[lane + 64]), fmaxf(bias[lane + 128], bias[lane + 192])); bmx = fmaxf(bmx, bias[256]);
        bmx = fmaxf(bmx, __shfl_xor(bmx, 1)); bmx = fmaxf(bmx, __shfl_xor(bmx, 2)); bmx = fmaxf(bmx, __shfl_xor(bmx, 4)); bmx = fmaxf(bmx, __shfl_xor(bmx, 8)); bmx = fmaxf(bmx, __shfl_xor(bmx, 16)); bmx = fmaxf(bmx, __shfl_xor(bmx, 32));
        float mfix[2];
#pragma unroll
        for (int qt = 0; qt < 2; ++qt) { float q2 = 0.f;
#pragma unroll
            for (int ks = 0; ks < 4; ++ks)
#pragma unroll
                for (int e = 0; e < 8; ++e) { const float v = bf2f((bf16_t)qf[qt][ks][e]); q2 += v * v; }
            q2 += __shfl_xor(q2, 16); q2 += __shfl_xor(q2, 32);
            mfix[qt] = 16.0f * sqrtf(q2) + bmx; }
        float l_run[2] = {0.f, 0.f};
        f32x4 o[2][8];
#pragma unroll
        for (int qt = 0; qt < 2; ++qt)
#pragma unroll
            for (int dt = 0; dt < 8; ++dt) o[qt][dt] = (f32x4){0.f, 0.f, 0.f, 0.f};
        const int kc0 = c > 8 ? c - 8 : 0, kb_end = (c + 1) * 2;
        bf16x8 kf[2][4];
#define ATT_LOADK(KF, kb_) do { const int k0_ = (kb_) * 32; \
            _Pragma("unroll") for (int t = 0; t < 2; ++t) { const bf16_t* kp = Kb + (size_t)(k0_ + 8 * (fr >> 2) + 4 * t + (fr & 3)) * kstride + 8 * fq; \
                _Pragma("unroll") for (int ks = 0; ks < 4; ++ks) KF[t][ks] = *(const bf16x8*)(kp + 32 * ks); } } while (0)
        ATT_LOADK(kf, kc0 * 2);
        for (int kb = kc0 * 2; kb < kb_end; ++kb) {
            const int k0 = kb * 32;
            bf16x8 vf[8];
            { const bf16_t* vp = Vb + (size_t)fr * vstride + k0 + 8 * fq;
#pragma unroll
              for (int dt = 0; dt < 8; ++dt) vf[dt] = *(const bf16x8*)(vp + (size_t)(16 * dt) * vstride); }
            f32x4 s[2][2];
#pragma unroll
            for (int qt = 0; qt < 2; ++qt)
#pragma unroll
                for (int t = 0; t < 2; ++t) { s[qt][t] = (f32x4){0.f, 0.f, 0.f, 0.f};
#pragma unroll
                    for (int ks = 0; ks < 4; ++ks) s[qt][t] = __builtin_amdgcn_mfma_f32_16x16x32_bf16(kf[t][ks], qf[qt][ks], s[qt][t], 0, 0, 0); }
            ATT_LOADK(kf, kb + 1 < kb_end ? kb + 1 : kb);
            const bool far = qpos0 - (k0 + 31) >= 128;
#pragma unroll
            for (int qt = 0; qt < 2; ++qt) {
                const int qpos = qpos0 + 16 * qt; const float mf = mfix[qt];
                float ps = 0.f;
                if (far) { const float bfar = bias[256] - mf;
#pragma unroll
                    for (int t = 0; t < 2; ++t)
#pragma unroll
                        for (int r = 0; r < 4; ++r) { s[qt][t][r] = __expf(s[qt][t][r] + bfar); ps += s[qt][t][r]; }
                } else {
#pragma unroll
                    for (int t = 0; t < 2; ++t)
#pragma unroll
                        for (int r = 0; r < 4; ++r) { int rel = qpos - (k0 + 8 * fq + 4 * t + r); rel = rel > 128 ? 128 : (rel < -128 ? -128 : rel); s[qt][t][r] = __expf(s[qt][t][r] + bias[rel + 128] - mf); ps += s[qt][t][r]; }
                }
                l_run[qt] += ps;
                u32x4 pw; pw.x = cvt_pk_bf16(s[qt][0][0], s[qt][0][1]); pw.y = cvt_pk_bf16(s[qt][0][2], s[qt][0][3]); pw.z = cvt_pk_bf16(s[qt][1][0], s[qt][1][1]); pw.w = cvt_pk_bf16(s[qt][1][2], s[qt][1][3]);
                bf16x8 pf; __builtin_memcpy(&pf, &pw, 16);
#pragma unroll
                for (int dt = 0; dt < 8; ++dt) o[qt][dt] = __builtin_amdgcn_mfma_f32_16x16x32_bf16(vf[dt], pf, o[qt][dt], 0, 0, 0);
            }
        }
#undef ATT_LOADK
#pragma unroll
        for (int qt = 0; qt < 2; ++qt) {
            float lt = l_run[qt]; lt += __shfl_xor(lt, 16); lt += __shfl_xor(lt, 32);
            const float inv = 1.0f / lt;
            bf16_t* op = OATT + (size_t)(row0 + 16 * qt + fr) * DM + h * 128 + 4 * fq;
#pragma unroll
            for (int dt = 0; dt < 8; ++dt) { const f32x4 v = o[qt][dt] * inv; u32x2 w; w.x = cvt_pk_bf16(v[0], v[1]); w.y = cvt_pk_bf16(v[2], v[3]); *(u32x2*)(op + 16 * dt) = w; }
        }
    }
}

__device__ __forceinline__ void phase_att(const Params& P, int wv, LAS unsigned char* lds) {
    unsigned char* ws = P.ws; const bf16_t* QKV = (const bf16_t*)(ws + AR_QKV); const bf16_t* VTP = (const bf16_t*)(ws + AR_VTP); bf16_t* OATT = (bf16_t*)(ws + AR_OATT); const float* relb = P.in[I_RELB];
    const int tid_ = fresh_tid(wv), lane = tid_ & 63, fr = lane & 15, fq = lane >> 4, wid = __builtin_amdgcn_readfirstlane(tid_ >> 6);
    LAS float* lbias = (LAS float*)(lds + 65536);
    for (int wgi = blockIdx.x; wgi < 4 * 16 * 16; wgi += gridDim.x) {
        const int b = wgi >> 8, h = (wgi >> 4) & 15, cq = wgi & 15, c = 4 * cq + (wid >> 1), qs = wid & 1, row0 = b * 4096 + c * 64 + qs * 32;
        const bf16_t* Kb = QKV + (size_t)(b * 4096) * 6144 + 2048 + h * 128; const bf16_t* Vb = VTP + ((size_t)(b * 16 + h) * 128) * 4096; const int kstride = 6144, vstride = 4096;
        const float* bias = relb + h * 257;
        bf16x8 qf[2][4];
#pragma unroll
        for (int qt = 0; qt < 2; ++qt) { const bf16_t* qp = QKV + (size_t)(row0 + 16 * qt + fr) * 6144 + h * 128 + 8 * fq;
#pragma unroll
            for (int ks = 0; ks < 4; ++ks) qf[qt][ks] = *(const bf16x8*)(qp + 32 * ks); }
        const int qpos0 = c * 64 + qs * 32 + fr;
        float bmx = fmaxf(fmaxf(bias[lane], bias[lane + 64]), fmaxf(bias[lane + 128], bias[lane + 192])); bmx = fmaxf(bmx, bias[256]);
        bmx = fmaxf(bmx, __shfl_xor(bmx, 1)); bmx = fmaxf(bmx, __shfl_xor(bmx, 2)); bmx = fmaxf(bmx, __shfl_xor(bmx, 4)); bmx = fmaxf(bmx, __shfl_xor(bmx, 8)); bmx = fmaxf(bmx, __shfl_xor(bmx, 16)); bmx = fmaxf(bmx, __shfl_xor(bmx, 32));
        float mfix[2];
#pragma unroll
        for (int qt = 0; qt < 2; ++qt) { float q2 = 0.f;
#pragma unroll
            for (int ks = 0; ks < 4; ++ks)
#pragma unroll
                for (int e = 0; e < 8; ++e) { const float v = bf2f((bf16_t)qf[qt][ks][e]); q2 += v * v; }
            q2 += __shfl_xor(q2, 16); q2 += __shfl_xor(q2, 32);
            mfix[qt] = 16.0f * sqrtf(q2) + bmx; }
        float l_run[2] = {0.f, 0.f};
        f32x4 o[2][8];
#pragma unroll
        for (int qt = 0; qt < 2; ++qt)
#pragma unroll
            for (int dt = 0; dt < 8; ++dt) o[qt][dt] = (f32x4){0.f, 0.f, 0.f, 0.f};
        const int kt0 = cq >= 2 ? 4 * cq - 8 : 0, kt1 = 4 * cq + 3;
        bf16x8 pre[4];
#define ATT_FETCH(kt_) do { const int k0_ = (kt_) * 64 + 32 * ((wid & 3) >> 1); \
            if (wid < 4) { const bf16_t* kp = Kb + (size_t)(k0_ + 8 * (fr >> 2) + 4 * (wid & 1) + (fr & 3)) * kstride + 8 * fq; \
                _Pragma("unroll") for (int j = 0; j < 4; ++j) pre[j] = *(const bf16x8*)(kp + 32 * j); } \
            else { const bf16_t* vp = Vb + (size_t)(64 * (wid & 1) + fr) * vstride + k0_ + 8 * fq; \
                _Pragma("unroll") for (int j = 0; j < 4; ++j) pre[j] = *(const bf16x8*)(vp + (size_t)(16 * j) * vstride); } } while (0)
#define ATT_PARK(buf_) do { _Pragma("unroll") for (int j = 0; j < 4; ++j) *(LAS bf16x8*)(lds + (buf_) * 32768 + (4 * wid + j) * 1024 + lane * 16) = pre[j]; } while (0)
        __syncthreads();
        ATT_FETCH(kt0); ATT_PARK(0);
        if (tid_ < 257) lbias[tid_] = bias[tid_];
        __syncthreads();
        for (int kt = kt0; kt <= kt1; ++kt) {
            const int buf = (kt - kt0) & 1;
            if (kt < kt1) ATT_FETCH(kt + 1);
            if (kt >= c - 8 && kt <= c) {
#pragma unroll
                for (int blk = 0; blk < 2; ++blk) {
                    const int k0 = kt * 64 + 32 * blk;
                    const LAS unsigned char* fb = lds + buf * 32768 + lane * 16;
                    bf16x8 kf[2][4], vf[8];
#pragma unroll
                    for (int t = 0; t < 2; ++t)
#pragma unroll
                        for (int ks = 0; ks < 4; ++ks) kf[t][ks] = *(const LAS bf16x8*)(fb + (blk * 8 + t * 4 + ks) * 1024);
#pragma unroll
                    for (int dt = 0; dt < 8; ++dt) vf[dt] = *(const LAS bf16x8*)(fb + (16 + blk * 8 + dt) * 1024);
                    f32x4 s[2][2];
                    __builtin_amdgcn_s_setprio(1);
#pragma unroll
                    for (int qt = 0; qt < 2; ++qt)
#pragma unroll
                        for (int t = 0; t < 2; ++t) { s[qt][t] = (f32x4){0.f, 0.f, 0.f, 0.f};
#pragma unroll
                            for (int ks = 0; ks < 4; ++ks) s[qt][t] = __builtin_amdgcn_mfma_f32_16x16x32_bf16(kf[t][ks], qf[qt][ks], s[qt][t], 0, 0, 0); }
                    __builtin_amdgcn_s_setprio(0);
                    const bool far = qpos0 - (k0 + 31) >= 128;
#pragma unroll
                    for (int qt = 0; qt < 2; ++qt) {
                        const int qpos = qpos0 + 16 * qt; const float mf = mfix[qt];
                        float ps = 0.f;
                        if (far) { const float bfar = bias[256] - mf;
#pragma unroll
                            for (int t = 0; t < 2; ++t)
#pragma unroll
                                for (int r = 0; r < 4; ++r) { s[qt][t][r] = __expf(s[qt][t][r] + bfar); ps += s[qt][t][r]; }
                        } else {
#pragma unroll
                            for (int t = 0; t < 2; ++t)
#pragma unroll
                                for (int r = 0; r < 4; ++r) { int rel = qpos - (k0 + 8 * fq + 4 * t + r); rel = rel > 128 ? 128 : (rel < -128 ? -128 : rel); s[qt][t][r] = __expf(s[qt][t][r] + lbias[rel + 128] - mf); ps += s[qt][t][r]; }
                        }
                        l_run[qt] += ps;
                        u32x4 pw; pw.x = cvt_pk_bf16(s[qt][0][0], s[qt][0][1]); pw.y = cvt_pk_bf16(s[qt][0][2], s[qt][0][3]); pw.z = cvt_pk_bf16(s[qt][1][0], s[qt][1][1]); pw.w = cvt_pk_bf16(s[qt][1][2], s[qt][1][3]);
                        bf16x8 pf; __builtin_memcpy(&pf, &pw, 16);
                        __builtin_amdgcn_s_setprio(1);
#pragma unroll
                        for (int dt = 0; dt < 8; ++dt) o[qt][dt] = __builtin_amdgcn_mfma_f32_16x16x32_bf16(vf[dt], pf, o[qt][dt], 0, 0, 0);
                        __builtin_amdgcn_s_setprio(0);
                    }
                }
            }
            if (kt < kt1) ATT_PARK(buf ^ 1);
            __syncthreads();
        }
#undef ATT_FETCH
#undef ATT_PARK
#pragma unroll
        for (int qt = 0; qt < 2; ++qt) {
            float lt = l_run[qt]; lt += __shfl_xor(lt, 16); lt += __shfl_xor(lt, 32);
            const float inv = 1.0f / lt;
            bf16_t* op = OATT + (size_t)(row0 + 16 * qt + fr) * DM + h * 128 + 4 * fq;
#pragma unroll
            for (int dt = 0; dt < 8; ++dt) { const f32x4 v = o[qt][dt] * inv; u32x2 w; w.x = cvt_pk_bf16(v[0], v[1]); w.y = cvt_pk_bf16(v[2], v[3]); *(u32x2*)(op + 16 * dt) = w; }
        }
    }
}
__device__ __forceinline__ void phase_qkn(const Params& P, int wv) {
    unsigned char* ws = P.ws; bf16_t* QKVP = (bf16_t*)(ws + AR_QKVP); const bf16_t* HALO = (const bf16_t*)(ws + AR_HALO); const float* wconv = P.in[I_WBCONV]; const float* histB = P.in[I_STBC];
    const int tid_ = fresh_tid(wv), lane = tid_ & 63, gw = blockIdx.x * 8 + (tid_ >> 6), nw = gridDim.x * 8;
    constexpr int NWI = (MT / 64) * 32;
    unsigned raw[64], nraw[64];
#define QKN_LOAD(BUF, wi_) do { const unsigned* rp_ = (const unsigned*)(QKVP + (size_t)(((wi_) >> 5) * 64) * DNC + ((wi_) & 31) * 128 + 2 * lane); \
        _Pragma("unroll") for (int i = 0; i < 64; ++i) BUF[i] = rp_[(size_t)i * (DNC / 2)]; } while (0)
#pragma unroll
    for (int i = 0; i < 64; ++i) { raw[i] = 0u; nraw[i] = 0u; }
    int wi = gw;
    if (wi < NWI) QKN_LOAD(raw, wi);
    for (; wi < NWI; wi += nw) {
        const int ch = wi >> 5, sl = wi & 31, col = sl * 128 + 2 * lane, r0 = ch * 64; int b, s0, S; row_pos(r0, b, s0, S);
        float w0[4], w1[4];
#pragma unroll
        for (int j = 0; j < 4; ++j) { w0[j] = wconv[j * DNC + col]; w1[j] = wconv[j * DNC + col + 1]; }
        float a0[3], a1[3];
#pragma unroll
        for (int j = 0; j < 3; ++j) {
            if (s0 > 0) { const unsigned hw = *(const unsigned*)(HALO + ((size_t)(ch - 1) * 3 + j) * 4096 + col); a0[j] = bflo(hw); a1[j] = bfhi(hw); }
            else if (r0 >= MP) { const float* hp = histB + ((size_t)b * 3 + j) * DNC + col; a0[j] = hp[0]; a1[j] = hp[1]; }
            else { a0[j] = 0.f; a1[j] = 0.f; }
        }
        if (wi + nw < NWI) QKN_LOAD(nraw, wi + nw);
        const float qsc = sl < 16 ? 0.08838834764831845f : 1.0f;
        unsigned* rp = (unsigned*)(QKVP + (size_t)r0 * DNC + col);
#pragma unroll
        for (int i = 0; i < 64; ++i) {
            const float x0 = bflo(raw[i]), x1 = bfhi(raw[i]);
            float y0 = w0[0] * a0[0] + w0[1] * a0[1] + w0[2] * a0[2] + w0[3] * x0, y1 = w1[0] * a1[0] + w1[1] * a1[1] + w1[2] * a1[2] + w1[3] * x1;
            y0 = siluf_(y0); y1 = siluf_(y1);
            const float sc = rsqrtf(wave_sum(y0 * y0 + y1 * y1) + EPS) * qsc;
            rp[(size_t)i * (DNC / 2)] = cvt_pk_bf16(y0 * sc, y1 * sc);
            a0[0] = a0[1]; a0[1] = a0[2]; a0[2] = x0; a1[0] = a1[1]; a1[1] = a1[2]; a1[2] = x1;
        }
#pragma unroll
        for (int i = 0; i < 64; ++i) raw[i] = nraw[i];
    }
#undef QKN_LOAD
}

#include <type_traits>
typedef short bf16x4 __attribute__((ext_vector_type(4)));
template <int K> __device__ __forceinline__ f32x4 tile_mma(const LAS bf16_t* A, int lda, const LAS bf16_t* Bt, int ldb, int m0, int n0, f32x4 acc, int fr, int fq) {
#pragma unroll
    for (int k0 = 0; k0 < K; k0 += 32) {
        const bf16x8 a = *(const LAS bf16x8*)(A + (m0 + fr) * lda + k0 + 8 * fq);
        const bf16x8 b = *(const LAS bf16x8*)(Bt + (n0 + fr) * ldb + k0 + 8 * fq);
        acc = __builtin_amdgcn_mfma_f32_16x16x32_bf16(b, a, acc, 0, 0, 0);
    }
    return acc;
}
__device__ __forceinline__ f32x4 tile_mma16(const LAS bf16_t* A, int lda, const LAS bf16_t* Bt, int ldb, f32x4 acc, int fr, int fq) {
    const bf16x4 a = *(const LAS bf16x4*)(A + fr * lda + 4 * fq);
    const bf16x4 b = *(const LAS bf16x4*)(Bt + fr * ldb + 4 * fq);
    return __builtin_amdgcn_mfma_f32_16x16x16bf16_1k(b, a, acc, 0, 0, 0);
}
constexpr int DR_LD = 0, DR_MISC = 4352, DR_CW = 5376, DR_LB = 10496, DR_TB = 19712, DR_KN = 28928, DR_TT = DR_KN, DR_PT = DR_KN + 9216, DR_QN = 46336, DR_KDT = 63744, DR_RT = 82176, DR_VNT = 91392,
              DR_VBT = 100608, DR_AI = 109824, DR_ST = 119040, DR_END = 136448;

#ifdef DBG_DR_DUMP
#define DR_DUMP(slot) do { if (item == 8 && n == 0) { __syncthreads(); for (int i_ = tid0; i_ < DR_END / 4; i_ += NTH) ((unsigned*)(ws + WS_END))[(size_t)(slot) * (DR_END / 4) + i_] = ((const LAS unsigned*)lds)[i_]; __syncthreads(); } } while (0)
#else
#define DR_DUMP(slot) do { } while (0)
#endif
#ifdef DR_SETPRIO
#define DR_PRIO(x) __builtin_amdgcn_s_setprio(x)
#else
#define DR_PRIO(x) do { } while (0)
#endif
template <int SKIP = 0>
__device__ __forceinline__ void phase_dr(const Params& P, int wv, LAS unsigned char* lds) {
    unsigned char* ws = P.ws; const bf16_t* QKVP = (const bf16_t*)(ws + AR_QKVP); bf16_t* ODR = (bf16_t*)(ws + AR_ODR); const float* BA = (const float*)(ws + WS_BA);
    const float* wconv = P.in[I_WBCONV]; const float* histB = P.in[I_STBC];
    LAS float* LD = (LAS float*)(lds + DR_LD); LAS bf16_t* LB = (LAS bf16_t*)(lds + DR_LB); LAS bf16_t* TB = (LAS bf16_t*)(lds + DR_TB); LAS bf16_t* TT = (LAS bf16_t*)(lds + DR_TT); LAS bf16_t* PT = (LAS bf16_t*)(lds + DR_PT);
    LAS bf16_t* KN = (LAS bf16_t*)(lds + DR_KN); LAS bf16_t* QN = (LAS bf16_t*)(lds + DR_QN); LAS bf16_t* KDT = (LAS bf16_t*)(lds + DR_KDT); LAS bf16_t* RT = (LAS bf16_t*)(lds + DR_RT); LAS bf16_t* VNT = (LAS bf16_t*)(lds + DR_VNT);
    LAS bf16_t* VBT = (LAS bf16_t*)(lds + DR_VBT); LAS bf16_t* AI = (LAS bf16_t*)(lds + DR_AI); LAS bf16_t* ST = (LAS bf16_t*)(lds + DR_ST);
    LAS float* GC = (LAS float*)(lds + DR_MISC); LAS float* BETA = GC + 64; LAS float* EG = GC + 128; LAS float* BEG = GC + 192; LAS float* CW = (LAS float*)(lds + DR_CW);
    const int tid0 = fresh_tid(wv), lane0 = tid0 & 63, wid0 = __builtin_amdgcn_readfirstlane(tid0 >> 6);
    const __amdgpu_buffer_rsrc_t rsrc_ = __builtin_amdgcn_make_buffer_rsrc((void*)QKVP, 0, (int)((size_t)MT * DNC * 2), 0x00020000);
    for (int item = blockIdx.x; item < 256 + 1024; item += gridDim.x) {
        int b, hv, half, rowbase, nchunks; bool samp;
        if (item < 256) { samp = false; b = item >> 6; hv = (item >> 1) & 31; half = item & 1; rowbase = b * SEQ; nchunks = SEQ / 64; }
        else { const int it = item - 256; samp = true; b = it >> 6; hv = (it >> 1) & 31; half = it & 1; rowbase = MP + b * DSEQ; nchunks = 1; }
        const int hk = hv >> 1;
        { const int lane = launder_v(lane0), wid = launder_s(wid0);
          const int cq = hk * 128 + 2 * lane, ck = 2048 + hk * 128 + 2 * lane, cvv = 4096 + hv * 128 + half * 64 + lane;
          if (wid == 0) {
#pragma unroll
            for (int j = 0; j < 4; ++j) { CW[(j * 5 + 0) * 64 + lane] = wconv[j * DNC + cq]; CW[(j * 5 + 1) * 64 + lane] = wconv[j * DNC + cq + 1]; CW[(j * 5 + 2) * 64 + lane] = wconv[j * DNC + ck];
                CW[(j * 5 + 3) * 64 + lane] = wconv[j * DNC + ck + 1]; CW[(j * 5 + 4) * 64 + lane] = wconv[j * DNC + cvv]; }
          }
          for (int i = wid * 64 + lane; i < 64 * 36; i += NTH) ((LAS unsigned*)TB)[i] = 0u;
        }
        auto run_item = [&](auto role_tag) {
        constexpr int ROLE = decltype(role_tag)::value;
        const int lane_i = launder_v(lane0), wid_i = launder_s(wid0), smt = wid_i - 4;
        f32x4 sacc[8];
        float* ssm_out = (samp ? P.out + O_SBS : P.out + O_PBS) + ((size_t)(b * 32 + hv) * 128) * 128;
        { const int fr = lane_i & 15, fq = lane_i >> 4;
#pragma unroll
          for (int j = 0; j < 8; ++j) {
            if (ROLE == 1 && samp && wid_i >= 4) { const float* sp = P.in[I_STBS] + ((size_t)(b * 32 + hv) * 128) * 128 + half * 64 + 16 * smt + fr;
#pragma unroll
                for (int r = 0; r < 4; ++r) sacc[j][r] = sp[(size_t)(16 * j + 4 * fq + r) * 128]; }
            else sacc[j] = (f32x4){0.f, 0.f, 0.f, 0.f};
            u32x2 w; w.x = cvt_pk_bf16(sacc[j][0], sacc[j][1]); w.y = cvt_pk_bf16(sacc[j][2], sacc[j][3]);
            if (ROLE == 1 && wid_i >= 4) *(LAS u32x2*)(ST + (16 * smt + fr) * 136 + 16 * j + 4 * fq) = w;
          } }
        unsigned pq[10], pk[10], pd[10], pv[5]; float pgc = 0.f, pbeta = 0.f;
        unsigned rq[10], rk[10], rv[13]; float rbeta = 0.f, rg = 0.f;
#define DR_LOADRAW(nn) do { if constexpr (ROLE == 1 && !(SKIP & 2)) { const int lane = launder_v(lane0), wq_ = launder_s(wid0) - 1; \
            const int cq = hk * 128 + 2 * lane, ck = 2048 + hk * 128 + 2 * lane, cvv = 4096 + hv * 128 + half * 64 + lane; \
            const float* bap = BA + (size_t)(rowbase + (nn) * 64 + lane) * 64; rbeta = bap[hv]; rg = bap[32 + hv]; \
            const int t0 = wq_ == 0 ? 0 : 1 + 9 * wq_, cnt = wq_ == 0 ? 10 : 9, p0 = (nn) * 64 + t0 - 3; \
            _Pragma("unroll") for (int i = 0; i < 13; ++i) { const int p = p0 + i; \
                if (p >= 0 && i - 3 < cnt) { const unsigned so_ = (unsigned)(rowbase + p) * (unsigned)(DNC * 2);     \
                    if (i >= 3) { rq[i - 3] = __builtin_amdgcn_raw_buffer_load_b32(rsrc_, 2 * cq, so_, 0); rk[i - 3] = __builtin_amdgcn_raw_buffer_load_b32(rsrc_, 2 * ck, so_, 0); } \
                    rv[i] = (unsigned)(unsigned short)__builtin_amdgcn_raw_buffer_load_b16(rsrc_, 2 * cvv, so_, 0); } \
                else if (p < 0 && samp) { const float* hp = histB + ((size_t)b * 3 + (3 + p)) * DNC; rv[i] = (unsigned)f2bf(hp[cvv]); } \
                else { rv[i] = 0u; if (i >= 3) { rq[i - 3] = 0u; rk[i - 3] = 0u; } } } } } while (0)
#define DR_PRECOMPUTE(nn) do { if constexpr (ROLE == 1 && !(SKIP & 2)) { const int lane = launder_v(lane0), wq_ = launder_s(wid0) - 1; \
            pbeta = rbeta; float g_ = rg; \
            _Pragma("unroll") for (int d = 1; d < 64; d <<= 1) { const float v_ = __shfl_up(g_, d); if (lane >= d) g_ += v_; } \
            pgc = g_; const float gl_ = __int_as_float(__builtin_amdgcn_readlane(__float_as_int(g_), 63)); \
            float wvv[4]; \
            _Pragma("unroll") for (int j = 0; j < 4; ++j) wvv[j] = CW[(j * 5 + 4) * 64 + lane]; \
            const int t0 = wq_ == 0 ? 0 : 1 + 9 * wq_; \
            float xv[13]; unsigned cq_[10], ck_[10]; \
            _Pragma("unroll") for (int i = 0; i < 13; ++i) xv[i] = bflo(rv[i]); \
            _Pragma("unroll") for (int i = 0; i < 10; ++i) { cq_[i] = rq[i]; ck_[i] = rk[i]; } \
            if ((nn) + 1 < nchunks) DR_LOADRAW((nn) + 1);                             \
            _Pragma("unroll") for (int i = 0; i < 10; ++i) { \
                float v = 0.f; \
                _Pragma("unroll") for (int j = 0; j < 4; ++j) v += wvv[j] * xv[i + j]; \
                v = siluf_(v); \
                const float k0 = bflo(ck_[i]), k1 = bfhi(ck_[i]); \
                const int tt = t0 + i < 64 ? t0 + i : 63; const float gt_ = __int_as_float(__builtin_amdgcn_readlane(__float_as_int(g_), tt)), bt_ = __int_as_float(__builtin_amdgcn_readlane(__float_as_int(pbeta), tt)); \
                const float kd = __expf(gl_ - gt_); \
                pq[i] = cq_[i]; pk[i] = ck_[i]; pd[i] = cvt_pk_bf16(k0 * kd, k1 * kd); \
                if (i & 1) pv[i >> 1] |= ((unsigned)f2bf(v * bt_)) << 16; else pv[i >> 1] = (unsigned)f2bf(v * bt_); } } } while (0)
        __syncthreads();
        DR_LOADRAW(0);
        DR_PRECOMPUTE(0);
        __syncthreads();
        for (int n = 0; n < nchunks; ++n) {
            const int crow = rowbase + n * 64;
            if constexpr (ROLE == 1) { const int lane = launder_v(lane0), wq_ = launder_s(wid0) - 1, t0 = wq_ == 0 ? 0 : 1 + 9 * wq_, cnt = wq_ == 0 ? 10 : 9;
                if (wq_ == 0) { const float eg_ = __expf(pgc); GC[lane] = pgc; BETA[lane] = pbeta; EG[lane] = eg_; BEG[lane] = pbeta * eg_; }
#pragma unroll
                for (int i = 0; i < 10; ++i) { const int t = t0 + i;
                    if (i < cnt) { *(LAS unsigned*)(QN + t * 136 + 2 * lane) = pq[i]; *(LAS unsigned*)(KN + t * 136 + 2 * lane) = pk[i];
                        KDT[(2 * lane) * 72 + t] = (bf16_t)(pd[i] & 0xffffu); KDT[(2 * lane + 1) * 72 + t] = (bf16_t)(pd[i] >> 16);
                        VBT[lane * 72 + t] = (bf16_t)((i & 1) ? (pv[i >> 1] >> 16) : (pv[i >> 1] & 0xffffu)); } }
            }
            __syncthreads();
            DR_DUMP(0);
            if constexpr (!(SKIP & 4)) { const int lane = launder_v(lane0), wid = launder_s(wid0), fr = lane & 15, fq = lane >> 4;
#pragma unroll
            for (int e = 0; e < 2; ++e) {
                const int id = 2 * wid + e, mt = id >> 2, nt = id & 3, i = 16 * mt + fr, j0 = 16 * nt + 4 * fq;
                f32x4 la = (f32x4){0.f, 0.f, 0.f, 0.f}, aa = (f32x4){0.f, 0.f, 0.f, 0.f};
                if (nt <= mt) {
                    la = tile_mma<128>(KN, 136, KN, 136, 16 * mt, 16 * nt, la, fr, fq);
                    aa = tile_mma<128>(QN, 136, KN, 136, 16 * mt, 16 * nt, aa, fr, fq);
                    const float gi = GC[i], bi = BETA[i];
#pragma unroll
                    for (int r = 0; r < 4; ++r) { const int j = j0 + r; const float dec = j <= i ? __expf(gi - GC[j]) : 0.f; aa[r] *= dec; la[r] = j < i ? la[r] * dec * bi : 0.f; }
                    if (nt == mt) {
#pragma unroll
                        for (int r = 0; r < 4; ++r) LD[(mt * 16 + fr) * 17 + 4 * fq + r] = la[r]; }
                }
                u32x2 w; w.x = cvt_pk_bf16(la[0], la[1]); w.y = cvt_pk_bf16(la[2], la[3]); *(LAS u32x2*)(LB + i * 72 + j0) = w;
                w.x = cvt_pk_bf16(aa[0], aa[1]); w.y = cvt_pk_bf16(aa[2], aa[3]); *(LAS u32x2*)(AI + i * 72 + j0) = w;
                { const int dv = 16 * mt + fr; f32x4 ra = (f32x4){0.f, 0.f, 0.f, 0.f};
                  ra = tile_mma<128>(ST, 136, KN, 136, 16 * mt, 16 * nt, ra, fr, fq);
                  const u32x2 vb = *(const LAS u32x2*)(VBT + dv * 72 + j0);
                  w.x = cvt_pk_bf16(bflo(vb.x) - BEG[j0] * ra[0], bfhi(vb.x) - BEG[j0 + 1] * ra[1]); w.y = cvt_pk_bf16(bflo(vb.y) - BEG[j0 + 2] * ra[2], bfhi(vb.y) - BEG[j0 + 3] * ra[3]);
                  *(LAS u32x2*)(RT + dv * 72 + j0) = w; }
            } }
            __syncthreads();
            DR_DUMP(1);
            if constexpr (ROLE == 1) { if (n + 1 < nchunks) DR_PRECOMPUTE(n + 1); }
            else if constexpr (!(SKIP & 1)) {
                DR_PRIO(3);
                const int lane = launder_v(lane0), fr = lane & 15, fq = lane >> 4, bk = lane >> 4, c = lane & 15;
                float x[16];
#pragma unroll
                for (int i = 0; i < 16; ++i) { float a = (i == c) ? 1.0f : 0.f;
#pragma unroll
                    for (int j = 0; j < i; ++j) a -= LD[(bk * 16 + i) * 17 + j] * x[j];
                    x[i] = a; }
#pragma unroll
                for (int i = 0; i < 16; ++i) TB[(16 * bk + i) * 72 + 16 * bk + c] = f2bf(x[i]);
#pragma unroll
                for (int i = 0; i < 16; i += 2) *(LAS unsigned*)(TT + (16 * bk + c) * 72 + 16 * bk + i) = cvt_pk_bf16(x[i], x[i + 1]);
                { const int zr = 16 + (lane >> 2), zc = 4 * (lane & 3); *(LAS u32x2*)(TT + zr * 72 + zc) = (u32x2){0u, 0u}; }
                asm volatile("s_waitcnt lgkmcnt(0)" ::: "memory");
#pragma unroll
                for (int p = 0; p < 2; ++p) { const int lo = 32 * p, hi = 32 * p + 16;
                    f32x4 a = (f32x4){0.f, 0.f, 0.f, 0.f};
                    a = tile_mma16(LB + hi * 72 + lo, 72, TT + lo * 72 + lo, 72, a, fr, fq);
#pragma unroll
                    for (int r = 0; r < 4; ++r) PT[(16 * p + 4 * fq + r) * 40 + fr] = f2bf(a[r]);
                }
                asm volatile("s_waitcnt lgkmcnt(0)" ::: "memory");
#pragma unroll
                for (int p = 0; p < 2; ++p) { const int lo = 32 * p, hi = 32 * p + 16;
                    f32x4 a = (f32x4){0.f, 0.f, 0.f, 0.f};
                    a = tile_mma16(TB + hi * 72 + hi, 72, PT + (16 * p) * 40, 40, a, fr, fq);
                    u32x2 w; w.x = cvt_pk_bf16(-a[0], -a[1]); w.y = cvt_pk_bf16(-a[2], -a[3]); *(LAS u32x2*)(TB + (hi + fr) * 72 + lo + 4 * fq) = w;
#pragma unroll
                    for (int r = 0; r < 4; ++r) TT[(lo + 4 * fq + r) * 72 + hi + fr] = f2bf(-a[r]);
                }
                asm volatile("s_waitcnt lgkmcnt(0)" ::: "memory");
#pragma unroll
                for (int mt = 0; mt < 2; ++mt)
#pragma unroll
                    for (int nt = 0; nt < 2; ++nt) { f32x4 a = (f32x4){0.f, 0.f, 0.f, 0.f};
                        a = tile_mma<32>(LB + 32 * 72, 72, TT, 72, 16 * mt, 16 * nt, a, fr, fq);
#pragma unroll
                        for (int r = 0; r < 4; ++r) PT[(16 * nt + 4 * fq + r) * 40 + 16 * mt + fr] = f2bf(a[r]); }
                asm volatile("s_waitcnt lgkmcnt(0)" ::: "memory");
#pragma unroll
                for (int mt = 0; mt < 2; ++mt)
#pragma unroll
                    for (int nt = 0; nt < 2; ++nt) { f32x4 a = (f32x4){0.f, 0.f, 0.f, 0.f};
                        a = tile_mma<32>(TB + 32 * 72 + 32, 72, PT, 40, 16 * mt, 16 * nt, a, fr, fq);
                        u32x2 w; w.x = cvt_pk_bf16(-a[0], -a[1]); w.y = cvt_pk_bf16(-a[2], -a[3]); *(LAS u32x2*)(TB + (32 + 16 * mt + fr) * 72 + 16 * nt + 4 * fq) = w; }
                DR_PRIO(0);
            }
            __syncthreads();
            DR_DUMP(2);
            if constexpr (!(SKIP & 8)) { const int lane = launder_v(lane0), wid = launder_s(wid0), fr = lane & 15, fq = lane >> 4;
#pragma unroll
            for (int e = 0; e < 2; ++e) {
                const int id = 2 * wid + e, mt = id >> 2, nt = id & 3, dv = 16 * mt + fr, t0 = 16 * nt + 4 * fq;
                f32x4 a = (f32x4){0.f, 0.f, 0.f, 0.f};
                a = tile_mma<64>(RT, 72, TB, 72, 16 * mt, 16 * nt, a, fr, fq);
                u32x2 w; w.x = cvt_pk_bf16(a[0], a[1]); w.y = cvt_pk_bf16(a[2], a[3]);
                *(LAS u32x2*)(VNT + dv * 72 + t0) = w;
            } }
            __syncthreads();
            DR_DUMP(4);
            if constexpr (!(SKIP & 8)) { const int lane = launder_v(lane0), wid = launder_s(wid0), fr = lane & 15, fq = lane >> 4;
#pragma unroll
            for (int e = 0; e < 2; ++e) {
                const int id = 2 * wid + e, mt = id >> 2, nt = id & 3, i = 16 * mt + fr;
                f32x4 a = (f32x4){0.f, 0.f, 0.f, 0.f};
                a = tile_mma<128>(QN, 136, ST, 136, 16 * mt, 16 * nt, a, fr, fq);
                a = a * EG[i];
                a = tile_mma<64>(AI, 72, VNT, 72, 16 * mt, 16 * nt, a, fr, fq);
                u32x2 w; w.x = cvt_pk_bf16(a[0], a[1]); w.y = cvt_pk_bf16(a[2], a[3]);
                *(u32x2*)(ODR + (size_t)(crow + i) * DNV + hv * 128 + half * 64 + 16 * nt + 4 * fq) = w;
#ifdef DBG_DR_DUMP
                if (item == 8 && n == 0) *(f32x4*)((float*)(ws + WS_END + 5 * (size_t)DR_END) + i * 64 + 16 * nt + 4 * fq) = a;
#endif
            }
            { const float dl = EG[63];
              if (ROLE == 1 && wid >= 4) {
#pragma unroll
              for (int j = 0; j < 8; ++j) { sacc[j] = sacc[j] * dl; sacc[j] = tile_mma<64>(VNT, 72, KDT, 72, 16 * smt, 16 * j, sacc[j], fr, fq); } } }
            __syncthreads();
#pragma unroll
            for (int j = 0; j < 8; ++j) { u32x2 w; w.x = cvt_pk_bf16(sacc[j][0], sacc[j][1]); w.y = cvt_pk_bf16(sacc[j][2], sacc[j][3]); if (ROLE == 1 && wid >= 4) *(LAS u32x2*)(ST + (16 * smt + fr) * 136 + 16 * j + 4 * fq) = w; }
            }
        }
        __syncthreads();
        { const int fr = lane_i & 15, fq = lane_i >> 4;
        if (ROLE == 1 && wid_i >= 4) {
#pragma unroll
        for (int j = 0; j < 8; ++j)
#pragma unroll
            for (int r = 0; r < 4; ++r) ssm_out[(size_t)(16 * j + 4 * fq + r) * 128 + half * 64 + 16 * smt + fr] = sacc[j][r];
        } }
#undef DR_PRECOMPUTE
#undef DR_LOADRAW
        };
        if (wid0 < 1) run_item(std::integral_constant<int, 0>{}); else run_item(std::integral_constant<int, 1>{});
        __syncthreads();
    }
}

__device__ __forceinline__ void phase_eb(const Params& P, int wv) {
    unsigned char* ws = P.ws; bf16_t* ODR = (bf16_t*)(ws + AR_ODR); const bf16_t* Z = (const bf16_t*)(ws + AR_Z); const float* go = P.in[I_GBOUT];
    const int tid_ = fresh_tid(wv), lane = tid_ & 63, gw = blockIdx.x * 8 + (tid_ >> 6), nw = gridDim.x * 8;
    float g[8];
#pragma unroll
    for (int e = 0; e < 8; ++e) g[e] = go[(lane & 15) * 8 + e];
    u32x4 co[8], cz[8], no_[8], nz[8];
#define EB_LOAD(O_, Z_, row_) do { _Pragma("unroll") for (int it = 0; it < 8; ++it) { const size_t off_ = (size_t)(row_) * DNV + (it * 64 + lane) * 8; O_[it] = *(const u32x4*)(ODR + off_); Z_[it] = *(const u32x4*)(Z + off_); } } while (0)
#pragma unroll
    for (int it = 0; it < 8; ++it) { co[it] = (u32x4){0u, 0u, 0u, 0u}; cz[it] = co[it]; no_[it] = co[it]; nz[it] = co[it]; }
    int row = gw;
    if (row < MT) EB_LOAD(co, cz, row);
    for (; row < MT; row += nw) {
        if (row + nw < MT) EB_LOAD(no_, nz, row + nw);
#pragma unroll
        for (int it = 0; it < 8; ++it) {
            const size_t off = (size_t)row * DNV + (it * 64 + lane) * 8;
            float o[8], z[8];
            o[0] = bflo(co[it].x); o[1] = bfhi(co[it].x); o[2] = bflo(co[it].y); o[3] = bfhi(co[it].y); o[4] = bflo(co[it].z); o[5] = bfhi(co[it].z); o[6] = bflo(co[it].w); o[7] = bfhi(co[it].w);
            z[0] = bflo(cz[it].x); z[1] = bfhi(cz[it].x); z[2] = bflo(cz[it].y); z[3] = bfhi(cz[it].y); z[4] = bflo(cz[it].z); z[5] = bfhi(cz[it].z); z[6] = bflo(cz[it].w); z[7] = bfhi(cz[it].w);
            float sq = 0.f;
#pragma unroll
            for (int e = 0; e < 8; ++e) sq += o[e] * o[e];
            sq += __shfl_xor(sq, 1); sq += __shfl_xor(sq, 2); sq += __shfl_xor(sq, 4); sq += __shfl_xor(sq, 8);
            const float rs = rsqrtf(sq * (1.0f / 128.0f) + EPS);
#pragma unroll
            for (int e = 0; e < 8; ++e) o[e] = o[e] * rs * g[e] * siluf_(z[e]);
            u32x4 w; w.x = cvt_pk_bf16(o[0], o[1]); w.y = cvt_pk_bf16(o[2], o[3]); w.z = cvt_pk_bf16(o[4], o[5]); w.w = cvt_pk_bf16(o[6], o[7]);
            *(u32x4*)(ODR + off) = w;
        }
#pragma unroll
        for (int it = 0; it < 8; ++it) { co[it] = no_[it]; cz[it] = nz[it]; }
    }
#undef EB_LOAD
}
constexpr int LDS_BYTES = 147456;
static_assert(DR_END + 16 <= LDS_BYTES && pg8::STAGE_BYTES + 16 <= LDS_BYTES, "lds");
#ifndef TAILK
#define TAILK true
#endif
constexpr int NPH = 1 + 4 * 13 + 1;

__global__ void __launch_bounds__(NTH, 2) mega(Params P0) {
    extern __shared__ __attribute__((aligned(16))) unsigned char lds_raw[];
    LAS unsigned char* lds = (LAS unsigned char*)lds_raw;
    unsigned char* ws0 = P0.ws;
    const int wv = __builtin_amdgcn_readfirstlane((int)threadIdx.x >> 6);
    volatile LAS unsigned* xbw = (volatile LAS unsigned*)(lds + LDS_BYTES - 16);
    if (threadIdx.x == 0) { xbw[0] = 0u; xbw[1] = 0u; xbw[2] = 0u; xbw[3] = 0u; }
    __syncthreads();
    XcdBarrier bar = xcd_barrier_post((unsigned*)(ws0 + WS_CTL), xbw);
#define SSV(k) (SS + (size_t)(k) * MT)
    bool need_bar = false;
#ifdef TS_A
#define TS_CAP(p) do { if (((p) == TS_A || (p) == TS_B) && launder_s((int)blockIdx.x) == 0 && fresh_tid(wv) == 0) ((volatile unsigned long long*)(P0.ws + WS_CTL + 32768))[(p) == TS_B ? 1 : 0] = __builtin_amdgcn_s_memrealtime(); } while (0)
#else
#define TS_CAP(p) do { } while (0)
#endif
    int hbsel = 0;
    int ph = 0;
#define PHASE_BEGIN(active) if ((active) && ph >= P0.pb && ph < P0.pe) { if (need_bar) xcd_barrier(bar, wv); need_bar = true; TS_CAP(ph); asm volatile("; === PHASE SITE line %0" :: "n"(__LINE__)); const Params& P = P0; unsigned char* ws = P.ws; asm volatile("" : "+s"(ws)); \
        float* H = (float*)(ws + WS_H); bf16_t* HB = (bf16_t*)(ws + WS_HB + (size_t)(hbsel & 1) * HB_STRIDE); bf16_t* HBN = (bf16_t*)(ws + WS_HB + (size_t)((hbsel + 1) & 1) * HB_STRIDE); (void)HBN; ssq_t* SS = (ssq_t*)(ws + WS_SS); const int G = launder_s((int)gridDim.x), wg = launder_s((int)blockIdx.x); (void)H; (void)HB; (void)SS; (void)G; (void)wg;
#define PHASE_END } ++ph;

#ifndef REPEAT
#define REPEAT -1
#endif
#define REP(k, ...) do { if (REPEAT == (k)) { xcd_barrier(bar, wv); __VA_ARGS__; } } while (0)
    PHASE_BEGIN(true) phase_prologue(P, wv, lds); REP(0, phase_prologue(P, wv, lds)); if (REPEAT == 99) { for (int i_ = 0; i_ < 32; ++i_) xcd_barrier(bar, wv); } PHASE_END

    for (int L = 0; L < 4; ++L) {
        hbsel = L;
        const int kind = L % 3, ja = L / 3;
        PHASE_BEGIN(kind == 0) {
            pg8::Gemm g{HB, (const bf16_t*)(ws + WS_WAIN) + (size_t)ja * 6144 * 2048, MT, 6144, 2048};
            pg8::StaticOrder S; S.init(MT, 6144, 2048, G, wg, false);
            EpiA1 E{SSV(3 * L), (bf16_t*)(ws + AR_BG), (bf16_t*)(ws + AR_CV), P.out + O_PA + (size_t)ja * NBP * 2 * DM, P.out + O_SA + (size_t)ja * NBS * 2 * DM};
            pg8::gemm_phase(lds, g, S, E, wv);
            if (L == 0) REP(1, pg8::gemm_phase(lds, g, S, E, wv));
            if (L == 0) REP(11, pg8::gemm_phase(lds, g, S, EpiNull{}, wv));
            if (L == 0) REP(12, { pg8::Gemm g2 = g; g2.bmul = 0; pg8::gemm_phase(lds, g2, S, EpiNull{}, wv); });
            if (L == 0) REP(13, { pg8::Gemm g2 = g; g2.bmul = 0; g2.amul = 0; pg8::gemm_phase(lds, g2, S, EpiNull{}, wv); });
#define RX_(...) { xcd_barrier(bar, wv); pg8::gemm_phase(lds, g, S, E, wv); __VA_ARGS__; }
            if (L == 0 && REPEAT == 21) { RX_() RX_() RX_() RX_() }
            if (L == 0 && REPEAT == 25) { for (int r_ = 0; r_ < 8; ++r_) { xcd_barrier(bar, wv); prep_fill<1>(P, wv, lds, S.nwg, launder_s(G), launder_s(wg)); } }
            if (L == 0 && REPEAT == 22) { RX_(prep_fill<99>(P, wv, lds, S.nwg, launder_s(G), launder_s(wg))) RX_(prep_fill<99>(P, wv, lds, S.nwg, launder_s(G), launder_s(wg))) RX_(prep_fill<99>(P, wv, lds, S.nwg, launder_s(G), launder_s(wg))) RX_(prep_fill<99>(P, wv, lds, S.nwg, launder_s(G), launder_s(wg))) }
#undef RX_
            if (L == 0) prep_fill<1>(P, wv, lds, S.nwg, launder_s(G), launder_s(wg)); else prep_fill<7>(P, wv, lds, S.nwg, launder_s(G), launder_s(wg));
        } PHASE_END
        PHASE_BEGIN(kind != 0) {
            pg8::Gemm g; pg8::StaticOrder S; EpiRowScale E;
            if (kind == 1) { g = pg8::Gemm{HB, (const bf16_t*)(ws + WS_WBIN), MT, 12288, 2048};
                E = EpiRowScale{SSV(3 * L), (bf16_t*)(ws + AR_QKVP), DNC, DNC, (bf16_t*)(ws + AR_Z), DNV, 3, DNC, P.out + O_PBC, P.out + O_SBC, (bf16_t*)(ws + AR_HALO)}; }
            else { g = pg8::Gemm{HB, (const bf16_t*)(ws + WS_WCQKV), MT, 6144, 2048};
                E = EpiRowScale{SSV(3 * L), (bf16_t*)(ws + AR_QKV), 6144, 1 << 30, nullptr, 0, 0, 0, nullptr, nullptr, nullptr}; }
            S.init(MT, g.N, 2048, G, wg, false);
            pg8::gemm_phase(lds, g, S, E, wv);
            if (kind == 1) prep_fill<3>(P, wv, lds, S.nwg, launder_s(G), launder_s(wg)); else prep_fill<5>(P, wv, lds, S.nwg, launder_s(G), launder_s(wg));
        } PHASE_END
        PHASE_BEGIN(kind == 1) { phase_ba(P, wv, SSV(3 * L), HB); phase_qkn(P, wv); } PHASE_END
        PHASE_BEGIN(true) {
            if (kind == 0) { phase_ea(P, wv, ja); if (L == 0) REP(2, phase_ea(P, wv, ja)); if (L == 0 && REPEAT == 26) { for (int r_ = 0; r_ < 8; ++r_) { xcd_barrier(bar, wv); phase_ea(P, wv, ja); } } }
            else if (kind == 1) {
#if REPEAT >= 30 && REPEAT < 46
                phase_dr<REPEAT - 30>(P, wv, lds); xcd_barrier(bar, wv);
#endif
                phase_dr(P, wv, lds); REP(3, phase_dr(P, wv, lds)); if (REPEAT == 46) { for (int r_ = 0; r_ < 4; ++r_) { xcd_barrier(bar, wv); phase_dr(P, wv, lds); } } }
            else phase_ec(P, wv, lds);
        } PHASE_END
        PHASE_BEGIN(kind != 0) {
            if (kind == 1) phase_eb(P, wv);
            else { phase_att(P, wv, lds); phase_att_sample(P, wv); REP(4, { phase_att(P, wv, lds); phase_att_sample(P, wv); }); if (REPEAT == 29) { for (int r_ = 0; r_ < 8; ++r_) { xcd_barrier(bar, wv); phase_att(P, wv, lds); phase_att_sample(P, wv); } } }
        } PHASE_END
        PHASE_BEGIN(true) {
            pg8::Gemm g;
            if (kind == 0) g = pg8::Gemm{(const bf16_t*)(ws + AR_AA), (const bf16_t*)(ws + WS_WAOUT) + (size_t)ja * 2048 * 2048, MT, 2048, 2048};
            else if (kind == 1) g = pg8::Gemm{(const bf16_t*)(ws + AR_ODR), (const bf16_t*)(ws + WS_WBOUT), MT, 2048, 4096};
            else g = pg8::Gemm{(const bf16_t*)(ws + AR_OATT), (const bf16_t*)(ws + WS_WCOUT), MT, 2048, 2048};
            pg8::StaticOrder S; S.init(MT, 2048, g.K, G, wg, TAILK);
            EpiResid<false> E{H, HB, HB, SSV(3 * L + 1), nullptr, nullptr};
            pg8::gemm_phase(lds, g, S, E, wv, (float*)(ws + (kind != 0 ? AR_PART_B : AR_PART)));
        } PHASE_END
        PHASE_BEGIN(TAILK) phase_reduce(P, wv, kind == 1 ? 4096 : 2048, (const float*)(ws + (kind != 0 ? AR_PART_B : AR_PART)), SSV(3 * L + 1), nullptr, HB, HB);
            if (L == 0 && REPEAT == 27) { for (int r_ = 0; r_ < 16; ++r_) { xcd_barrier(bar, wv); phase_reduce(P, wv, 2048, (const float*)(ws + AR_PART), (ssq_t*)(ws + WS_H + HB_STRIDE), nullptr, HB, (bf16_t*)(ws + WS_H)); } }
            if (L == 0 && REPEAT == 28) { for (int r_ = 0; r_ < 16; ++r_) { xcd_barrier(bar, wv); } } PHASE_END
        PHASE_BEGIN(true) {
            pg8::Gemm g{HB, (const bf16_t*)(ws + WS_WFUP) + (size_t)L * DFF2 * 2048, MT, DFF2, 2048};
            pg8::StaticOrder S; S.init(MT, DFF2, 2048, G, wg, false);
            EpiGlu E{SSV(3 * L + 1), (bf16_t*)(ws + AR_ACT), (float*)(ws + AR_XB), P.in[I_WFCONV] + (size_t)L * 3 * DFF2, P.in[I_BFCONV] + (size_t)L * DFF2, P.out + O_PF + (size_t)L * NBP * 2 * DFF2, P.out + O_SF + (size_t)L * NBS * 2 * DFF2};
            pg8::gemm_phase(lds, g, S, E, wv);
            if (L == 0) REP(5, pg8::gemm_phase(lds, g, S, E, wv));
            if (L == 0) REP(15, pg8::gemm_phase(lds, g, S, EpiNull{}, wv));
#define RX_(...) { xcd_barrier(bar, wv); pg8::gemm_phase(lds, g, S, E, wv); __VA_ARGS__; }
            if (L == 0 && REPEAT == 23) { RX_() RX_() RX_() RX_() }
            if (L == 0 && REPEAT == 24) { RX_(prep_fill<2>(P, wv, lds, S.nwg, launder_s(G), launder_s(wg))) RX_(prep_fill<2>(P, wv, lds, S.nwg, launder_s(G), launder_s(wg))) RX_(prep_fill<2>(P, wv, lds, S.nwg, launder_s(G), launder_s(wg))) RX_(prep_fill<2>(P, wv, lds, S.nwg, launder_s(G), launder_s(wg))) }
#undef RX_
            { const int G2 = launder_s(G), wg2 = launder_s(wg);
              if (L == 0) prep_fill<2>(P, wv, lds, S.nwg, G2, wg2); else if (L == 1) prep_fill<4>(P, wv, lds, S.nwg, G2, wg2); else if (L == 2) prep_fill<6>(P, wv, lds, S.nwg, G2, wg2); else prep_fill<8>(P, wv, lds, S.nwg, G2, wg2); }
        } PHASE_END
        PHASE_BEGIN(true) phase_ef(P, wv, L); if (L == 0) REP(6, phase_ef(P, wv, L)); PHASE_END
        PHASE_BEGIN(true) {
            { pg8::Gemm g{(const bf16_t*)(ws + AR_ACT), (const bf16_t*)(ws + WS_WFDOWN) + (size_t)L * 2048 * DFF, MT, 2048, DFF};
              pg8::StaticOrder S; S.init(MT, 2048, DFF, G, wg, TAILK);
              EpiResid<false> E{H, HB, HB, SSV(3 * L + 2), nullptr, nullptr};
              pg8::gemm_phase(lds, g, S, E, wv, (float*)(ws + AR_PART)); }
            { unsigned char* ws2 = ws; asm volatile("" : "+s"(ws2)); const int G2 = launder_s(G), wg2 = launder_s(wg);
              pg8::Gemm g{(const bf16_t*)(ws2 + WS_PB) + (size_t)L * MT * PLE, (const bf16_t*)(ws2 + WS_WPP) + (size_t)L * 2048 * PLE, MT, 2048, launder_s(PLE)};
              pg8::StaticOrder S; S.init(MT, 2048, PLE, G2, G2 - 1 - wg2, false);
              EpiPlain E{(bf16_t*)(ws2 + AR_PPB), DM};
              pg8::gemm_phase(lds, g, S, E, wv); }
#define RXF_ { xcd_barrier(bar, wv); \
              { pg8::Gemm g{(const bf16_t*)(ws + AR_ACT), (const bf16_t*)(ws + WS_WFDOWN), MT, 2048, DFF}; \
                pg8::StaticOrder S; S.init(MT, 2048, DFF, launder_s(G), launder_s(wg), TAILK); \
                EpiResid<false> E{H, HB, (bf16_t*)(ws + WS_H), (ssq_t*)(ws + WS_H + HB_STRIDE), nullptr, nullptr}; \
                pg8::gemm_phase(lds, g, S, E, wv, (float*)(ws + AR_PART)); } \
              { const int G2 = launder_s(G), wg2 = launder_s(wg); \
                pg8::Gemm g{(const bf16_t*)(ws + WS_PB), (const bf16_t*)(ws + WS_WPP), MT, 2048, launder_s(PLE)}; \
                pg8::StaticOrder S; S.init(MT, 2048, PLE, G2, G2 - 1 - wg2, false); \
                EpiPlain E{(bf16_t*)(ws + AR_PPB), DM}; \
                pg8::gemm_phase(lds, g, S, E, wv); } }
            if (L == 0 && REPEAT == 47) { RXF_ RXF_ }
#define RXP_ { xcd_barrier(bar, wv); { const int G2 = launder_s(G), wg2 = launder_s(wg); \
                pg8::Gemm g{(const bf16_t*)(ws + WS_PB), (const bf16_t*)(ws + WS_WPP), MT, 2048, launder_s(PLE)}; \
                pg8::StaticOrder S; S.init(MT, 2048, PLE, G2, G2 - 1 - wg2, false); \
                EpiPlain E{(bf16_t*)(ws + AR_PPB), DM}; \
                pg8::gemm_phase(lds, g, S, E, wv); } }
            if (L == 0 && REPEAT == 49) { RXP_ RXP_ RXP_ RXP_ }
#undef RXP_
#undef RXF_
        } PHASE_END
        PHASE_BEGIN(TAILK) phase_reduce(P, wv, DFF, (const float*)(ws + AR_PART), SSV(3 * L + 2), nullptr, HB, HB); PHASE_END
        PHASE_BEGIN(true) {
            pg8::Gemm g{HB, (const bf16_t*)(ws + WS_WPG) + (size_t)L * 2048 * 2048, MT, 2048, 2048};
            pg8::StaticOrder S; S.init(MT, 2048, 2048, G, wg, TAILK);
            EpiResid<true> E{H, HB, HBN, SSV(3 * L + 3), SSV(3 * L + 2), (const bf16_t*)(ws + AR_PPB)};
            pg8::gemm_phase(lds, g, S, E, wv, (float*)(ws + AR_PART));
        } PHASE_END
        PHASE_BEGIN(TAILK) phase_reduce(P, wv, 2048, (const float*)(ws + AR_PART), SSV(3 * L + 3), SSV(3 * L + 2), HB, HBN); PHASE_END
    }
    hbsel = 4;
    PHASE_BEGIN(true) phase_final(P, wv, HB); REP(7, phase_final(P, wv, HB)); PHASE_END
#undef PHASE_BEGIN
#undef PHASE_END
#ifdef TS_A
    xcd_barrier(bar, wv); TS_CAP(NPH);
    if (launder_s((int)blockIdx.x) == 0 && fresh_tid(wv) == 0) { volatile unsigned long long* tsp = (volatile unsigned long long*)(P0.ws + WS_CTL + 32768); const float us = (float)(long long)(tsp[1] - tsp[0]) * 0.01f; P0.out[0] = floorf(us / (float)TS_SCALE + 0.5f) * 1.0e9f; }
#endif
}
extern "C" void kernel_launch(void* const* d_in, const int* in_sizes, int n_in, void* d_out, int out_size, void* d_ws, size_t ws_size, hipStream_t stream) {
    static int grid = 0;
    if (grid == 0) {
        if (n_in != N_IN || out_size != (int)O_END || ws_size < WS_NEED) { fprintf(stderr, "kernel_launch: unexpected problem: n_in %d out %d ws %zu (need %zu)\n", n_in, out_size, ws_size, (size_t)WS_NEED); grid = -1; return; }
        int dev = 0, cus = 0;
        if (hipGetDevice(&dev) != hipSuccess || hipDeviceGetAttribute(&cus, hipDeviceAttributeMultiprocessorCount, dev) != hipSuccess) { grid = -1; return; }
        if (hipFuncSetAttribute((const void*)mega, hipFuncAttributeMaxDynamicSharedMemorySize, LDS_BYTES) != hipSuccess) { fprintf(stderr, "kernel_launch: hipFuncSetAttribute failed\n"); grid = -1; return; }
        int per_cu = 0;
        if (hipOccupancyMaxActiveBlocksPerMultiprocessor(&per_cu, (const void*)mega, NTH, LDS_BYTES) != hipSuccess || per_cu < 1) { fprintf(stderr, "kernel_launch: occupancy query says %d\n", per_cu); grid = -1; return; }
        grid = cus;
    }
    if (grid <= 0) return;
    (void)hipMemsetAsync((char*)d_ws + WS_CTL, 0, CTL_BYTES, stream);
    Params p{};
    for (int i = 0; i < N_IN; ++i) p.in[i] = (const float*)d_in[i];
    p.out = (float*)d_out; p.ws = (unsigned char*)d_ws;
#ifndef DBG
    p.pb = 0; p.pe = NPH;
    hipLaunchKernelGGL(mega, dim3(grid), dim3(NTH), LDS_BYTES, stream, p);
#else
    dbg_run(p, grid, stream);
#endif
}
```
